# Optimizing an MI355X kernel written in HIP

```python
import jax, jax.numpy as jnp
from jax import lax
import numpy as np

D_MODEL = 1024
BATCH = 2
SEQ = 8192
DEPTH = 2

GRID_W = 64
CTX_LEN = 256
HG_HEAD_DIM = 128
HG_DIM = D_MODEL
HG_HEADS = HG_DIM // HG_HEAD_DIM
CHUNK = 64
CV_DIM = D_MODEL
CONV_K = 31
FFN_DIM = ((8 * D_MODEL // 3 + 255) // 256) * 256
FFN_K = 3
N_MOD = 6
EPS = 1e-6
G_MIN = 1e-6
SPLIT_SIZES = (HG_DIM, HG_DIM, HG_DIM, HG_DIM, HG_DIM, CV_DIM, CV_DIM, D_MODEL, D_MODEL)
P_TOTAL = 5 * HG_DIM + 2 * CV_DIM + 2 * D_MODEL

kernel_name = 'hybrid_hgrn2_conformer_convffn_dit'


def rmsnorm(x, w):
    xf = x.astype(jnp.float32)
    y = xf * lax.rsqrt(jnp.mean(xf * xf, axis=-1, keepdims=True) + EPS)
    return (y * w.astype(jnp.float32)).astype(x.dtype)


def layernorm(x, w, b):
    xf = x.astype(jnp.float32)
    mu = jnp.mean(xf, axis=-1, keepdims=True)
    xc = xf - mu
    y = xc * lax.rsqrt(jnp.mean(xc * xc, axis=-1, keepdims=True) + EPS)
    return (y * w.astype(jnp.float32) + b.astype(jnp.float32)).astype(x.dtype)


def split_proj(p):
    return jnp.split(p, np.cumsum(SPLIT_SIZES)[:-1], axis=-1)


def heads(t):
    return t.reshape(t.shape[0], t.shape[1], HG_HEADS, HG_HEAD_DIM)


def dwconv1d(x, w, b):
    k = w.shape[0]
    y = lax.conv_general_dilated(x, w[:, None, :], window_strides=(1,), padding=[(k // 2, k // 2)],
                                 dimension_numbers=('NWC', 'WIO', 'NWC'), feature_group_count=x.shape[-1])
    return y + b


def dwconv2d(x, w, b):
    k = w.shape[0]
    y = lax.conv_general_dilated(x, w[:, :, None, :], window_strides=(1, 1),
                                 padding=[(k // 2, k // 2), (k // 2, k // 2)],
                                 dimension_numbers=('NHWC', 'HWIO', 'NHWC'), feature_group_count=x.shape[-1])
    return y + b


def gla_chunked(q, k, v, logf, s0):
    bsz, length, nh, _ = q.shape
    dv = v.shape[-1]
    n_chunks = length // CHUNK

    def to_chunks(t):
        return t.astype(jnp.float32).reshape(bsz, n_chunks, CHUNK, nh, t.shape[-1]).transpose(1, 0, 3, 2, 4)

    tril = jnp.tril(jnp.ones((CHUNK, CHUNK), dtype=bool))[:, :, None]

    def step(state, inp):
        qc, kc, vc, fc = inp
        b = jnp.cumsum(fc, axis=2)
        o_inter = jnp.einsum('bhtd,bhde->bhte', qc * jnp.exp(b), state)
        rel = b[:, :, :, None, :] - b[:, :, None, :, :]
        decay = jnp.where(tril, jnp.exp(jnp.minimum(rel, 0.0)), 0.0)
        scores = jnp.einsum('bhtd,bhsd,bhtsd->bhts', qc, kc, decay)
        o = o_inter + jnp.einsum('bhts,bhse->bhte', scores, vc)
        b_end = b[:, :, -1]
        new_state = jnp.exp(b_end)[..., None] * state + jnp.einsum(
            'bhsd,bhse->bhde', kc * jnp.exp(jnp.minimum(b_end[:, :, None, :] - b, 0.0)), vc)
        return new_state, o

    s_fin, o = lax.scan(step, s0.astype(jnp.float32),
                        (to_chunks(q), to_chunks(k), to_chunks(v), to_chunks(logf)))
    o = o.transpose(1, 0, 3, 2, 4).reshape(bsz, length, nh, dv)
    return o, s_fin


def hgrn2_gates(f_logit, lb):
    f = f_logit.astype(jnp.float32)
    lb = lb.astype(jnp.float32)
    g = lb + (1.0 - lb) * jax.nn.sigmoid(f)
    log_g = jnp.log(jnp.clip(g, G_MIN, 1.0))
    k = (1.0 - lb) * jax.nn.sigmoid(-f)
    return k, log_g


def hgrn2_bidir(q, i, f_fwd, f_bwd, lb_fwd, lb_bwd, s_fwd, s_bwd):
    q, i = heads(q), heads(i)
    k_f, lg_f = hgrn2_gates(heads(f_fwd), lb_fwd.reshape(HG_HEADS, HG_HEAD_DIM))
    k_b, lg_b = hgrn2_gates(heads(f_bwd), lb_bwd.reshape(HG_HEADS, HG_HEAD_DIM))
    o_f, sf = gla_chunked(q, k_f, i, lg_f, s_fwd)
    flip = lambda t: jnp.flip(t, axis=1)
    o_b, sb = gla_chunked(flip(q), flip(k_b), flip(i), flip(lg_b), s_bwd)
    return o_f + flip(o_b), sf, sb


def mixer_merge(o_hg, g, cv_a, cv_b, gate_hg, gate_cv, gn_w, w_hg_out, dw_w, dw_b, ln_w, ln_b, w_cv_out, w_out):
    bsz, length = g.shape[:2]
    o = rmsnorm(o_hg.astype(g.dtype), gn_w) * jax.nn.silu(heads(g))
    y_hg = o.reshape(bsz, length, HG_DIM) @ w_hg_out
    u = cv_a * jax.nn.sigmoid(cv_b)
    u = jax.nn.silu(layernorm(dwconv1d(u, dw_w, dw_b), ln_w, ln_b))
    y_cv = u @ w_cv_out
    y = jax.nn.sigmoid(gate_hg) * y_hg + jax.nn.sigmoid(gate_cv) * y_cv
    return y @ w_out


def conv_ffn(h, w_up, dw_w, dw_b, w_down):
    u, v = jnp.split(h @ w_up, 2, axis=-1)
    u = dwconv2d(u, dw_w, dw_b)
    return (jax.nn.gelu(u, approximate=False) * v) @ w_down


def setup_inputs(seed: int = 0) -> dict:
    key = jax.random.key(seed)
    ks = jax.random.split(key, 23)
    nrm = lambda k, shape, s: s * jax.random.normal(k, shape, jnp.float32)
    return {
        'x': nrm(ks[0], (BATCH, SEQ, D_MODEL), 1.0),
        'c': nrm(ks[1], (BATCH, D_MODEL), 1.0),
        'ctx': nrm(ks[2], (BATCH, CTX_LEN, D_MODEL), 1.0),
        'c_ctx': nrm(ks[3], (D_MODEL,), 1.0),
        'w_mod': nrm(ks[4], (DEPTH, D_MODEL, N_MOD * D_MODEL), 0.5 * D_MODEL ** -0.5),
        'b_mod': nrm(ks[5], (DEPTH, N_MOD * D_MODEL), 0.01),
        'norm1_w': 1.0 + nrm(ks[6], (DEPTH, D_MODEL), 0.02),
        'w_in': nrm(ks[7], (DEPTH, D_MODEL, P_TOTAL), D_MODEL ** -0.5),
        'hg_lb_logits': nrm(ks[8], (2, DEPTH, HG_DIM), 0.5),
        'hg_gnorm_w': 1.0 + nrm(ks[9], (DEPTH, HG_HEAD_DIM), 0.02),
        'w_hg_out': nrm(ks[10], (DEPTH, HG_DIM, D_MODEL), HG_DIM ** -0.5),
        'cv_dw_w': nrm(ks[11], (DEPTH, CONV_K, CV_DIM), CONV_K ** -0.5),
        'cv_dw_b': nrm(ks[12], (DEPTH, CV_DIM), 0.01),
        'cv_ln_w': 1.0 + nrm(ks[13], (DEPTH, CV_DIM), 0.02),
        'cv_ln_b': nrm(ks[14], (DEPTH, CV_DIM), 0.01),
        'w_cv_out': nrm(ks[15], (DEPTH, CV_DIM, D_MODEL), CV_DIM ** -0.5),
        'w_out': nrm(ks[16], (DEPTH, D_MODEL, D_MODEL), D_MODEL ** -0.5),
        'norm2_w': 1.0 + nrm(ks[17], (DEPTH, D_MODEL), 0.02),
        'w_up': nrm(ks[18], (DEPTH, D_MODEL, 2 * FFN_DIM), D_MODEL ** -0.5),
        'ffn_dw_w': nrm(ks[19], (DEPTH, FFN_K, FFN_K, FFN_DIM), 1.0 / FFN_K),
        'ffn_dw_b': nrm(ks[20], (DEPTH, FFN_DIM), 0.01),
        'w_down': nrm(ks[21], (DEPTH, FFN_DIM, D_MODEL), FFN_DIM ** -0.5),
        'final_norm_w': 1.0 + nrm(ks[22], (D_MODEL,), 0.02),
    }


def reference(x, c, ctx, c_ctx, w_mod, b_mod, norm1_w, w_in, hg_lb_logits, hg_gnorm_w, w_hg_out,
              cv_dw_w, cv_dw_b, cv_ln_w, cv_ln_b, w_cv_out, w_out, norm2_w, w_up, ffn_dw_w, ffn_dw_b,
              w_down, final_norm_w):
    bsz, length, _ = x.shape
    rows = length // GRID_W
    lb_sm = jax.nn.softmax(hg_lb_logits.astype(jnp.float32), axis=1)
    lbs = jnp.cumsum(lb_sm, axis=1) - lb_sm[:, :1]
    cx = ctx
    zero_state = jnp.zeros((bsz, HG_HEADS, HG_HEAD_DIM, HG_HEAD_DIM), jnp.float32)
    for l in range(DEPTH):
        mod = (jax.nn.silu(c) @ w_mod[l] + b_mod[l])[:, None, :]
        mod_c = jax.nn.silu(c_ctx) @ w_mod[l] + b_mod[l]
        sh1, sc1, gt1, sh2, sc2, gt2 = jnp.split(mod, N_MOD, axis=-1)
        csh1, csc1, cgt1, csh2, csc2, cgt2 = jnp.split(mod_c, N_MOD, axis=-1)

        h = rmsnorm(x, norm1_w[l]) * (1 + sc1) + sh1
        hc = rmsnorm(cx, norm1_w[l]) * (1 + csc1) + csh1
        pq, pff, pfb, pi, pg, pa, pb, pgh, pgc = split_proj(h @ w_in[l])
        cq, cff, cfb, ci, cg, ca, cb, cgh, cgc = split_proj(hc @ w_in[l])
        o_ctx, s_f, s_b = hgrn2_bidir(cq, ci, cff, cfb, lbs[0, l], lbs[1, l], zero_state, zero_state)
        o_lat, _, _ = hgrn2_bidir(pq, pi, pff, pfb, lbs[0, l], lbs[1, l], s_f, s_b)
        layer_w = (hg_gnorm_w[l], w_hg_out[l], cv_dw_w[l], cv_dw_b[l], cv_ln_w[l], cv_ln_b[l], w_cv_out[l], w_out[l])
        x = x + gt1 * mixer_merge(o_lat, pg, pa, pb, pgh, pgc, *layer_w)

        h2 = (rmsnorm(x, norm2_w[l]) * (1 + sc2) + sh2).reshape(bsz, rows, GRID_W, D_MODEL)
        x = x + gt2 * conv_ffn(h2, w_up[l], ffn_dw_w[l], ffn_dw_b[l], w_down[l]).reshape(bsz, length, D_MODEL)

        if l < DEPTH - 1:
            cx = cx + cgt1 * mixer_merge(o_ctx, cg, ca, cb, cgh, cgc, *layer_w)
            hc2 = (rmsnorm(cx, norm2_w[l]) * (1 + csc2) + csh2)[:, None]
            cx = cx + cgt2 * conv_ffn(hc2, w_up[l], ffn_dw_w[l], ffn_dw_b[l], w_down[l])[:, 0]
    return rmsnorm(x, final_norm_w)
```

```cpp
#include <hip/hip_runtime.h>
#include <cstdio>
#include <cstdint>

#ifndef MK_N_LAUNCHES
#define MK_N_LAUNCHES 1
#endif

#define LAS __attribute__((address_space(3)))
#define GAS __attribute__((address_space(1)))
typedef unsigned short bf16_t;
typedef short bf16x8 __attribute__((ext_vector_type(8)));
typedef float f32x4 __attribute__((ext_vector_type(4)));
typedef float f32x2 __attribute__((ext_vector_type(2)));
typedef float f32x16 __attribute__((ext_vector_type(16)));
typedef unsigned u32x4 __attribute__((ext_vector_type(4)));
typedef unsigned u32x2 __attribute__((ext_vector_type(2)));
typedef GAS unsigned gu32;

constexpr int D = 1024, BATCH = 2, SEQ = 8192, CTXL = 256, DEPTH = 2;
constexpr int ML = BATCH * SEQ, MC = BATCH * CTXL, MT = ML + MC;
constexpr int PIN = 9216, FFN = 2816, NUP = 2 * FFN, NH = 8, HD = 128, NMOD = 6 * D;
constexpr int GRIDW = 64, CONVK = 31;
constexpr float EPS = 1e-6f, GMIN = 1e-6f;
constexpr int NWAVES = 8, NTHR = 512;

constexpr size_t MiB = 1u << 20;
constexpr size_t RB = (size_t)MT * D * 2;
constexpr size_t WS_CTL = 0, CTL_ZERO_BYTES = 128 * 1024;
constexpr size_t WS_MODP = 1 * MiB;
constexpr size_t WS_MOD = WS_MODP + (size_t)2 * 16 * 3 * NMOD * 4;
constexpr size_t WS_BIASIN = WS_MOD + (size_t)2 * 3 * NMOD * 4;
constexpr size_t WS_BIASUP = WS_BIASIN + (size_t)2 * 3 * PIN * 4;
constexpr size_t WS_BIASP = WS_BIASUP + (size_t)2 * 3 * NUP * 4;
constexpr size_t WS_BIASP2 = WS_BIASP + (size_t)16 * 3 * PIN * 4;
constexpr size_t WS_SSQ = WS_BIASP2 + (size_t)16 * 3 * NUP * 4;
constexpr size_t WS_DV = WS_SSQ + (size_t)MT * 16 * 4;
constexpr size_t WS_CX = WS_DV + (size_t)1056 * 128 * 4;
constexpr size_t WS_SMALL_END = WS_CX + (size_t)MC * D * 4;
static_assert(WS_SMALL_END <= 11 * MiB, "small region");
constexpr size_t WS_W = 11 * MiB;
constexpr size_t WO_IN = 0, WO_HG = (size_t)PIN * D * 2, WO_CV = WO_HG + (size_t)D * D * 2, WO_OUT = WO_CV + (size_t)D * D * 2,
                 WO_UP = WO_OUT + (size_t)D * D * 2, WO_DOWN = WO_UP + (size_t)NUP * D * 2, WO_END = WO_DOWN + (size_t)D * FFN * 2;
static_assert(WO_END <= 41 * MiB, "weights");
constexpr size_t WS_XB = 52 * MiB;
constexpr size_t WS_BIG = 85 * MiB;
constexpr size_t WS_QV = WS_BIG;
constexpr size_t WS_S2 = WS_BIG + 2 * RB;
constexpr size_t WS_S3 = WS_BIG + 3 * RB;
constexpr size_t WS_ST = WS_BIG + 4 * RB;
constexpr size_t WS_UV = WS_BIG;
constexpr size_t WS_END = WS_BIG + 6 * RB;
static_assert(WS_END + 16 * 65536 <= 288 * MiB && (size_t)MT * NUP * 2 <= 6 * RB, "ws map");

constexpr int CW_BAR = 4096;
constexpr int CW_CNT_MOD = 8192;
constexpr int CW_CNT_IN = 8192 + 64;
constexpr int CW_CNT_UP = CW_CNT_IN + 2 * 288;
constexpr int CW_SPLIT = 20480;
constexpr int CW_FIN = 16384;

constexpr int RING_BYTES = 131072;
constexpr int LDSCTL_OFF = RING_BYTES + 8192;
constexpr int LDS_BYTES = 147456;

typedef __bf16 bf16x2_t __attribute__((ext_vector_type(2)));
__device__ __forceinline__ unsigned pk2(float lo, float hi) { const f32x2 v = {lo, hi}; const bf16x2_t b = __builtin_convertvector(v, bf16x2_t); return __builtin_bit_cast(unsigned, b); }
__device__ __forceinline__ unsigned f2bf(float f) { return pk2(f, f) & 0xffffu; }
__device__ __forceinline__ float bf2f(unsigned b) { return __builtin_bit_cast(float, (b & 0xffffu) << 16); }
__device__ __forceinline__ float bflo(unsigned w) { return __builtin_bit_cast(float, w << 16); }
__device__ __forceinline__ float bfhi(unsigned w) { return __builtin_bit_cast(float, w & 0xffff0000u); }
__device__ __forceinline__ unsigned pkh2(float lo, float hi) { _Float16 a = (_Float16)lo, b = (_Float16)hi; return (unsigned)__builtin_bit_cast(unsigned short, a) | ((unsigned)__builtin_bit_cast(unsigned short, b) << 16); }
__device__ __forceinline__ float sigmoidf_(float x) { return __builtin_amdgcn_rcpf(1.0f + __builtin_amdgcn_exp2f(x * -1.4426950408889634f)); }
__device__ __forceinline__ float siluf_(float x) { return x * sigmoidf_(x); }
__device__ __forceinline__ float rsqrtf_(float x) { return __builtin_amdgcn_rsqf(x); }
__device__ __forceinline__ float wave_sum(float v) {
#pragma unroll
    for (int o = 1; o < 64; o <<= 1) v += __shfl_xor(v, o);
    return v;
}
__device__ __forceinline__ f32x2 gelu_pk(f32x2 v) {
    const f32x2 av = __builtin_elementwise_abs(v), d = av * 0.2316418882f + 1.0f;
    f32x2 t; t.x = __builtin_amdgcn_rcpf(d.x); t.y = __builtin_amdgcn_rcpf(d.y);
    f32x2 q = t * 0.5307027145f + (-0.7265760135f); q = q * t + 0.7107068705f; q = q * t + (-0.142248368f); q = q * t + 0.127414796f; q = q * t;
    const f32x2 s = (v * v) * (-0.72134752044f);
    f32x2 e; e.x = __builtin_amdgcn_exp2f(s.x); e.y = __builtin_amdgcn_exp2f(s.y);
    const f32x2 m = v * (q * e), r = v - m;
    f32x2 o; o.x = v.x < 0.f ? m.x : r.x; o.y = v.y < 0.f ? m.y : r.y; return o;
}
#define LDS_WAIT() asm volatile("s_waitcnt lgkmcnt(0)" ::: "memory")
#define VM_WAIT() asm volatile("s_waitcnt vmcnt(0)" ::: "memory")
#define RLX_AGENT __ATOMIC_RELAXED, __HIP_MEMORY_SCOPE_AGENT

namespace pg8 {
constexpr int BM = 256, BK = 64, HALF = 128, HTB = HALF * BK * 2, STAGE_BYTES = 8 * HTB, NXCD = 8, WGM = 6;
__host__ __device__ __forceinline__ int lds_byte(int r, int c) { const int st = (r >> 4) * 2 + (c >> 5), rr = r & 15, cc = c & 31, ob = rr * 64 + cc * 2; return st * 1024 + (ob ^ (((ob >> 9) & 1) << 5)); }
__host__ __device__ __forceinline__ void stage_rc(int b, int& R, int& C) { const int st = b / 1024, sb = b % 1024, swz = sb ^ (((sb >> 9) & 1) << 5); R = (st >> 1) * 16 + swz / 64; C = (st & 1) * 32 + (swz % 64) / 2; }
__host__ __device__ __forceinline__ int perm32(int rho) { const int n = rho >> 4, i = rho & 15; return 8 * (i >> 2) + 4 * n + (i & 3); }
struct Unit { int pm, pn; };
struct Gemm { const bf16_t* A; const bf16_t* Bt; int M, N, K, lda; };
struct StaticOrder {
    int nM, nN, nwg, G, c;
    __device__ void init(int M, int N, int G_, int c_) { nM = M / BM; nN = N / BM; nwg = nM * nN; G = G_; c = c_; }
    __device__ bool next(int i, Unit& u) const {
        const long L = (long)i * G + c; if (L >= nwg) return false;
        int wgid = (int)L; { const int q = nwg / NXCD, r = nwg % NXCD, xcd = wgid % NXCD, off = wgid / NXCD; wgid = (xcd < r ? xcd * (q + 1) : r * (q + 1) + (xcd - r) * q) + off; }
        const int nig = WGM * nN, gid = wgid / nig, fm = gid * WGM, gsz = (nM - fm) < WGM ? (nM - fm) : WGM;
        u.pm = fm + ((wgid % nig) % gsz); u.pn = (wgid % nig) / gsz; return true;
    }
};
template <class Epi>
__device__ __forceinline__ void gemm_phase(LAS unsigned char* lds, const int tid, const Gemm g, const StaticOrder& S, const Epi& E) {
    const int wid = __builtin_amdgcn_readfirstlane(tid >> 6), lane = tid & 63, wr = wid >> 2, wc = wid & 3, fr = lane & 15, fq = lane >> 4;
    const int K = g.K, nt = K / BK, lda = g.lda;
    unsigned voffA[2], voffB[2];
#pragma unroll
    for (int i = 0; i < 2; ++i) { int R, C; stage_rc(tid * 16 + i * 8192, R, C); const int Rb = (R & ~31) + perm32(R & 31);
        voffA[i] = (unsigned)(R * lda + C) * 2u; voffB[i] = (unsigned)(Rb * K + C) * 2u; }
    const size_t kstep = (size_t)(BK * 2);
    const size_t hstepA = (size_t)HALF * lda * 2, hstepB = (size_t)HALF * K * 2;
    const size_t tstepA = 2 * hstepA, tstepB = 2 * hstepB;
    const unsigned ldsw = (unsigned)wid * 1024u;
    const int aoff = lds_byte(wr * 64 + fr, fq * 8), boff = lds_byte(wc * 32 + fr, fq * 8);
#define PG8_SA(b, h) (((b) * 2 + (h)) * HTB)
#define PG8_SB(b, h) ((4 + (b) * 2 + (h)) * HTB)
#define PG8_STAGE(bufoff, gbase, voff) do { _Pragma("unroll") for (int _i = 0; _i < 2; ++_i) \
        __builtin_amdgcn_global_load_lds((const unsigned*)((const char*)(gbase) + (voff)[_i]), (LAS unsigned*)(lds + (bufoff) + ldsw + _i * 8192), 16, 0, 0); } while (0)
#define PG8_LDA(dst, b, h) do { _Pragma("unroll") for (int m = 0; m < 4; ++m) _Pragma("unroll") for (int k = 0; k < 2; ++k) dst[m][k] = *(const LAS bf16x8*)(lds + PG8_SA(b, h) + aoff + m * 2048 + k * 1024); } while (0)
#define PG8_LDB(dst, b, h) do { _Pragma("unroll") for (int n = 0; n < 2; ++n) _Pragma("unroll") for (int k = 0; k < 2; ++k) dst[n][k] = *(const LAS bf16x8*)(lds + PG8_SB(b, h) + boff + n * 2048 + k * 1024); } while (0)
#define PG8_MMA(ai, bj, At, Bt) do { __builtin_amdgcn_s_setprio(1); _Pragma("unroll") for (int m = 0; m < 4; ++m) _Pragma("unroll") for (int n = 0; n < 2; ++n) _Pragma("unroll") for (int k = 0; k < 2; ++k) \
        acc[ai][bj][m][n] = __builtin_amdgcn_mfma_f32_16x16x32_bf16(Bt[n][k], At[m][k], acc[ai][bj][m][n], 0, 0, 0); __builtin_amdgcn_s_setprio(0); } while (0)
#define PG8_WAIT_V(n) asm volatile("s_waitcnt vmcnt(" #n ")" ::: "memory")
#define PG8_WAIT_L(n) asm volatile("s_waitcnt lgkmcnt(" #n ")" ::: "memory")
#define PG8_BAR __builtin_amdgcn_s_barrier()
#define PG8_SCHED __builtin_amdgcn_sched_barrier(0)
    Unit cur, nxt; int ui = 0;
    if (!S.next(0, cur)) return;
    f32x4 acc[2][2][4][2];
#pragma unroll
    for (int a = 0; a < 2; ++a)
#pragma unroll
        for (int b = 0; b < 2; ++b)
#pragma unroll
            for (int m = 0; m < 4; ++m)
#pragma unroll
                for (int n = 0; n < 2; ++n) acc[a][b][m][n] = (f32x4){0.f, 0.f, 0.f, 0.f};
    bf16x8 At[4][2], B0[2][2], B1[2][2];
    const char* cA = (const char*)g.A + (size_t)cur.pm * tstepA; const char* cB = (const char*)g.Bt + (size_t)cur.pn * tstepB;
    PG8_STAGE(PG8_SB(0, 0), cB, voffB); PG8_STAGE(PG8_SB(0, 1), cB + hstepB, voffB); PG8_STAGE(PG8_SA(0, 0), cA, voffA); PG8_STAGE(PG8_SA(0, 1), cA + hstepA, voffA);
    if (wr == 1) PG8_BAR;
    PG8_WAIT_V(2); PG8_BAR;
    PG8_STAGE(PG8_SB(1, 0), cB + kstep, voffB); PG8_STAGE(PG8_SA(1, 0), cA + kstep, voffA); PG8_STAGE(PG8_SB(1, 1), cB + hstepB + kstep, voffB);
    PG8_WAIT_V(6); PG8_BAR;
    for (;;) {
        const bool has_next = S.next(ui + 1, nxt);
        const char* nA = has_next ? (const char*)g.A + (size_t)nxt.pm * tstepA : cA; const char* nB = has_next ? (const char*)g.Bt + (size_t)nxt.pn * tstepB : cB;
        for (int t = 0; t < nt; t += 2) {
            const bool last = (t == nt - 2);
            const char* a1 = cA + (size_t)(t + 1) * kstep;
            const char* a2 = last ? nA : cA + (size_t)(t + 2) * kstep; const char* b2 = last ? nB : cB + (size_t)(t + 2) * kstep;
            const char* a3 = a2 + kstep; const char* b3 = b2 + kstep;
            PG8_LDB(B0, 0, 0); PG8_LDB(B1, 0, 1); PG8_SCHED; PG8_LDA(At, 0, 0); PG8_STAGE(PG8_SA(1, 1), a1 + hstepA, voffA);
            PG8_WAIT_V(8); PG8_WAIT_L(0); PG8_BAR; PG8_MMA(0, 0, At, B0); PG8_MMA(0, 1, At, B1); PG8_BAR; PG8_SCHED;
            PG8_LDA(At, 0, 1); PG8_STAGE(PG8_SB(0, 0), b2, voffB); PG8_STAGE(PG8_SB(0, 1), b2 + hstepB, voffB); PG8_STAGE(PG8_SA(0, 0), a2, voffA);
            PG8_WAIT_V(8); PG8_WAIT_L(0); PG8_BAR; PG8_MMA(1, 0, At, B0); PG8_MMA(1, 1, At, B1); PG8_BAR; PG8_SCHED;
            PG8_LDB(B0, 1, 0); PG8_LDB(B1, 1, 1); PG8_SCHED; PG8_LDA(At, 1, 0); PG8_STAGE(PG8_SA(0, 1), a2 + hstepA, voffA);
            PG8_WAIT_V(8); PG8_WAIT_L(0); PG8_BAR; PG8_MMA(0, 0, At, B0); PG8_MMA(0, 1, At, B1); PG8_BAR; PG8_SCHED;
            PG8_LDA(At, 1, 1); PG8_STAGE(PG8_SB(1, 0), b3, voffB); PG8_STAGE(PG8_SB(1, 1), b3 + hstepB, voffB); PG8_STAGE(PG8_SA(1, 0), a3, voffA);
            PG8_WAIT_V(8); PG8_WAIT_L(0); PG8_BAR; PG8_MMA(1, 0, At, B0); PG8_MMA(1, 1, At, B1); PG8_BAR; PG8_SCHED;
        }
        if (wr == 0) PG8_BAR;
        E(acc, cur, 0, wr, wc, fr, fq);
        if (!has_next) break;
#pragma unroll
        for (int a = 0; a < 2; ++a)
#pragma unroll
            for (int b = 0; b < 2; ++b)
#pragma unroll
                for (int m = 0; m < 4; ++m)
#pragma unroll
                    for (int n = 0; n < 2; ++n) acc[a][b][m][n] = (f32x4){0.f, 0.f, 0.f, 0.f};
        cur = nxt; cA = nA; cB = nB; ++ui;
        if (wr == 1) PG8_BAR;
    }
    PG8_WAIT_V(0);
    PG8_BAR;
#undef PG8_SA
#undef PG8_SB
#undef PG8_STAGE
#undef PG8_LDA
#undef PG8_LDB
#undef PG8_MMA
#undef PG8_WAIT_V
#undef PG8_WAIT_L
#undef PG8_BAR
#undef PG8_SCHED
}
template <class Epi>
__device__ __forceinline__ void gemm_sub(LAS unsigned char* lds, const int tid, const Gemm g, const Unit u, const int sub, const Epi& E) {
    const int wid = __builtin_amdgcn_readfirstlane(tid >> 6), lane = tid & 63, wr = wid >> 2, wc = wid & 3, fr = lane & 15, fq = lane >> 4;
    const int ro = (sub >> 2) * 128 + (sub & 3) * 16, K = g.K, nt = K / BK, lda = g.lda;
    constexpr int SBUF = 2 * HTB + 4096;
    unsigned voffB[2], voffA;
#pragma unroll
    for (int i = 0; i < 2; ++i) { int R, C; stage_rc(tid * 16 + i * 8192, R, C); const int Rb = (R & ~31) + perm32(R & 31); voffB[i] = (unsigned)(Rb * K + C) * 2u; }
    { int R, C; stage_rc((tid & 255) * 16, R, C); voffA = (unsigned)(((R & 15) + 64 * (R >> 4)) * lda + C) * 2u; }
    const char* cA = (const char*)g.A + (size_t)(u.pm * BM + ro) * lda * 2;
    const char* cB = (const char*)g.Bt + (size_t)u.pn * BM * K * 2;
    const size_t hstepB = (size_t)HALF * K * 2;
    const unsigned ldsw = (unsigned)wid * 1024u, ldswA = (unsigned)(wid & 3) * 1024u;
    const int aoff = lds_byte(wr * 16 + fr, fq * 8), boff = lds_byte(wc * 32 + fr, fq * 8);
#define PGS_STAGE(t_, b_) do { const char* gb_ = cB + (size_t)(t_) * (BK * 2); const char* ga_ = cA + (size_t)(t_) * (BK * 2); LAS unsigned char* lb_ = lds + (b_) * SBUF; \
        _Pragma("unroll") for (int h_ = 0; h_ < 2; ++h_) _Pragma("unroll") for (int i_ = 0; i_ < 2; ++i_) \
            __builtin_amdgcn_global_load_lds((const unsigned*)(gb_ + h_ * hstepB + voffB[i_]), (LAS unsigned*)(lb_ + h_ * HTB + ldsw + i_ * 8192), 16, 0, 0); \
        __builtin_amdgcn_global_load_lds((const unsigned*)(ga_ + voffA), (LAS unsigned*)(lb_ + 2 * HTB + ldswA), 16, 0, 0); } while (0)
    f32x4 acc[1][2][1][2];
#pragma unroll
    for (int bj = 0; bj < 2; ++bj)
#pragma unroll
        for (int n = 0; n < 2; ++n) acc[0][bj][0][n] = (f32x4){0.f, 0.f, 0.f, 0.f};
    __builtin_amdgcn_s_barrier();
    PGS_STAGE(0, 0); PGS_STAGE(1, 1);
    int bc = 0;
#pragma unroll 1
    for (int t = 0; t < nt; ++t) {
        if (t + 1 < nt) asm volatile("s_waitcnt vmcnt(5)" ::: "memory"); else asm volatile("s_waitcnt vmcnt(0)" ::: "memory");
        __builtin_amdgcn_s_barrier();
        if (t + 2 < nt) { const int bn = bc + 2 >= 3 ? bc - 1 : bc + 2; PGS_STAGE(t + 2, bn); }
        const LAS unsigned char* lb = lds + bc * SBUF;
        bf16x8 At[2], Bf[2][2][2];
#pragma unroll
        for (int k = 0; k < 2; ++k) At[k] = *(const LAS bf16x8*)(lb + 2 * HTB + aoff + k * 1024);
#pragma unroll
        for (int bj = 0; bj < 2; ++bj)
#pragma unroll
            for (int n = 0; n < 2; ++n)
#pragma unroll
                for (int k = 0; k < 2; ++k) Bf[bj][n][k] = *(const LAS bf16x8*)(lb + bj * HTB + boff + n * 2048 + k * 1024);
#pragma unroll
        for (int k = 0; k < 2; ++k)
#pragma unroll
            for (int bj = 0; bj < 2; ++bj)
#pragma unroll
                for (int n = 0; n < 2; ++n) acc[0][bj][0][n] = __builtin_amdgcn_mfma_f32_16x16x32_bf16(Bf[bj][n][k], At[k], acc[0][bj][0][n], 0, 0, 0);
        bc = bc + 1 == 3 ? 0 : bc + 1;
    }
#undef PGS_STAGE
    E(acc, u, ro, wr, wc, fr, fq);
}
}

#define XB_TMO      128
#define XB_XCNT(j)  (256  + 64 * (j))
#define XB_XSUB(j)  (1280 + 64 * (j))
#define XB_XGEN(j)  (2304 + 64 * (j))
#define XB_TOP      3328
#define XB_TOPGEN   3392
#define XCD_BAR_WORDS 3456
#define XB_SPIN_CAP (1u << 18)
__device__ __forceinline__ unsigned xb_ld(unsigned* p)              { return __hip_atomic_load(p, __ATOMIC_RELAXED, __HIP_MEMORY_SCOPE_AGENT); }
__device__ __forceinline__ unsigned xb_add(unsigned* p, unsigned v) { return __hip_atomic_fetch_add(p, v, __ATOMIC_RELAXED, __HIP_MEMORY_SCOPE_AGENT); }
__device__ __forceinline__ unsigned xb_xcc_id() { return (unsigned)__builtin_amdgcn_s_getreg((3 << 11) | 20) & 0xFu; }
#define XB_SPIN(cond, bar) do { unsigned _sp = 0; while (cond) { __builtin_amdgcn_s_sleep(1); \
    if ((++_sp & 255u) == 0u) { if (xb_ld(&(bar)[XB_TMO])) break; if (_sp > XB_SPIN_CAP) { atomicAdd(&(bar)[XB_TMO], 1u); break; } } } } while (0)
struct XcdBarrier { unsigned* bar; unsigned x; volatile LAS unsigned* st; };
__device__ __forceinline__ XcdBarrier xcd_barrier_post(unsigned* bar, volatile LAS unsigned* st, int tid) {
    XcdBarrier b; b.bar = bar; b.x = xb_xcc_id(); b.st = st;
    if (tid == 0) (void)xb_add(&bar[XB_XCNT(b.x)], 1u);
    return b;
}
__device__ __forceinline__ void xcd_barrier_complete(unsigned* bar, unsigned x, unsigned& nloc, unsigned& nx) {
    const unsigned G = gridDim.x * gridDim.y * gridDim.z;
    unsigned sum, cnt, mine, sp = 0u;
    for (;;) {
        sum = 0u; cnt = 0u; mine = 0u;
#pragma unroll
        for (unsigned j = 0; j < 16; ++j) { const unsigned c = xb_ld(&bar[XB_XCNT(j)]); sum += c; cnt += (c > 0u) ? 1u : 0u; mine = (j == x) ? c : mine; }
        if (sum == G) break;
        __builtin_amdgcn_s_sleep(1);
        if ((++sp & 255u) == 0u) { if (xb_ld(&bar[XB_TMO])) break; if (sp > XB_SPIN_CAP) { atomicAdd(&bar[XB_TMO], 1u); break; } }
    }
    nloc = mine > 0u ? mine : 1u; nx = cnt > 0u ? cnt : 1u;
}
__device__ __forceinline__ void xcd_barrier(const XcdBarrier& b, int tid) {
    asm volatile("s_waitcnt vmcnt(0)" ::: "memory");
    __syncthreads();
    if (tid == 0) {
        unsigned* bar = b.bar;
        __builtin_amdgcn_s_waitcnt(0);
        unsigned nloc = b.st[0], nx = b.st[1];
        if (nloc == 0u) { xcd_barrier_complete(bar, b.x, nloc, nx); b.st[0] = nloc; b.st[1] = nx; }
        const unsigned old = xb_add(&bar[XB_XSUB(b.x)], 1u);
        const unsigned gen = old / nloc;
        if (old + 1u == (gen + 1u) * nloc) {
            __builtin_amdgcn_fence(__ATOMIC_RELEASE, "agent");
            asm volatile("s_waitcnt vmcnt(0)" ::: "memory");
            const unsigned og = xb_add(&bar[XB_TOP], 1u);
            const unsigned tg = og / nx;
            if (og + 1u == (tg + 1u) * nx) xb_add(&bar[XB_TOPGEN], 1u);
            else XB_SPIN(xb_ld(&bar[XB_TOPGEN]) == tg, bar);
            __builtin_amdgcn_fence(__ATOMIC_ACQUIRE, "agent");
            xb_add(&bar[XB_XGEN(b.x)], 1u);
            asm volatile("s_waitcnt vmcnt(0)" ::: "memory");
        } else {
            XB_SPIN(xb_ld(&bar[XB_XGEN(b.x)]) == gen, bar);
            __builtin_amdgcn_fence(__ATOMIC_ACQUIRE, "agent");
            asm volatile("s_waitcnt vmcnt(0)" ::: "memory");
        }
    }
    __syncthreads();
}

#define XS_XCNT(j) (64 * (j))
#define XS_TOP 1024
__device__ __forceinline__ void split_arrive(const XcdBarrier& b, unsigned* w, int tid) {
    if (b.st == nullptr) return;
    asm volatile("s_waitcnt vmcnt(0)" ::: "memory");
    __syncthreads();
    if (tid == 0) {
        unsigned nloc = b.st[0], nx = b.st[1];
        if (nloc == 0u) { xcd_barrier_complete(b.bar, b.x, nloc, nx); b.st[0] = nloc; b.st[1] = nx; }
        const unsigned old = xb_add(&w[XS_XCNT(b.x)], 1u);
        if (old + 1u == nloc) {
            __builtin_amdgcn_fence(__ATOMIC_RELEASE, "agent");
            asm volatile("s_waitcnt vmcnt(0)" ::: "memory");
            xb_add(&w[XS_TOP], 1u);
        }
    }
}
__device__ __forceinline__ void split_wait(const XcdBarrier& b, unsigned* w, int tid) {
    if (b.st == nullptr) return;
    if (tid == 0) {
        const unsigned nx = b.st[1];
        XB_SPIN(xb_ld(&w[XS_TOP]) < nx, b.bar);
        __builtin_amdgcn_fence(__ATOMIC_ACQUIRE, "agent");
        asm volatile("s_waitcnt vmcnt(0)" ::: "memory");
    }
    __syncthreads();
}

struct Args { const float* in[23]; float* out; unsigned char* ws; int ph_lo, ph_hi; int probe_mask, pad; };
struct Frame {
    LAS unsigned char* lds;
    int tid, lane, wave, G, vcu;
    const Args* a; float* out; unsigned char* ws;
};
__device__ __forceinline__ int mod_index(int row) { return row < SEQ ? 0 : (row < ML ? 1 : 2); }
__device__ __forceinline__ float* xrow_ptr(const Frame& F, int row) { return row < ML ? F.out + (size_t)row * D : (float*)(F.ws + WS_CX) + (size_t)(row - ML) * D; }

template <bool BIAS>
__device__ __forceinline__ void transpose_item(const float* W, int K, int N, bf16_t* WT, int kb, int n0, int vrow0, LAS float* scr, int lane,
                                               const float* sh  , float* biasp, int ldb) {
    const int k0 = 64 * kb;
    float tv[32];
#pragma unroll
    for (int i = 0; i < 32; ++i) tv[i] = W[(size_t)(k0 + 2 * i + (lane >> 5)) * N + n0 + (lane & 31)];
#pragma unroll
    for (int i = 0; i < 32; ++i) scr[(2 * i + (lane >> 5)) * 33 + (lane & 31)] = tv[i];
    if (BIAS) { scr[64 * 33 + lane] = sh[k0 + lane]; scr[64 * 33 + 64 + lane] = sh[NMOD + k0 + lane]; scr[64 * 33 + 128 + lane] = sh[2 * NMOD + k0 + lane]; }
    LDS_WAIT(); asm volatile("" ::: "memory");
    const int c = lane & 7;
#pragma unroll
    for (int j = 0; j < 4; ++j) { const int n = (lane >> 3) + 8 * j; const LAS float* s = scr + (8 * c) * 33 + n;
        u32x4 o; o.x = pk2(s[0 * 33], s[1 * 33]); o.y = pk2(s[2 * 33], s[3 * 33]); o.z = pk2(s[4 * 33], s[5 * 33]); o.w = pk2(s[6 * 33], s[7 * 33]);
        *(GAS u32x4*)(WT + (size_t)(vrow0 + n) * K + k0 + 8 * c) = o; }
    if (BIAS) {
        const int n = lane & 31, hf = lane >> 5; float p0 = 0.f, p1 = 0.f, p2 = 0.f;
#pragma unroll 8
        for (int i = 0; i < 32; ++i) { const int kk = hf * 32 + i; const float w = scr[kk * 33 + n]; p0 += scr[64 * 33 + kk] * w; p1 += scr[64 * 33 + 64 + kk] * w; p2 += scr[64 * 33 + 128 + kk] * w; }
        p0 += __shfl_xor(p0, 32); p1 += __shfl_xor(p1, 32); p2 += __shfl_xor(p2, 32);
        if (lane < 32) { __hip_atomic_store(biasp + (size_t)(kb * 3 + 0) * ldb + vrow0 + n, p0, RLX_AGENT); __hip_atomic_store(biasp + (size_t)(kb * 3 + 1) * ldb + vrow0 + n, p1, RLX_AGENT); __hip_atomic_store(biasp + (size_t)(kb * 3 + 2) * ldb + vrow0 + n, p2, RLX_AGENT); }
    }
    LDS_WAIT(); asm volatile("" ::: "memory");
}
__device__ __forceinline__ void bias_finish(unsigned* cnt, const float* biasp, int ldb, int vrow0, float* bias  , int lane) {
    VM_WAIT();
    unsigned old = 0;
    if (lane == 0) old = __hip_atomic_fetch_add(cnt, 1u, RLX_AGENT);
    old = __builtin_amdgcn_readfirstlane(old);
    if ((old & 15u) == 15u) {
        if (lane < 32) {
#pragma unroll
            for (int j = 0; j < 3; ++j) { float s = 0.f;
#pragma unroll
                for (int kb = 0; kb < 16; ++kb) s += __hip_atomic_load(biasp + (size_t)(kb * 3 + j) * ldb + vrow0 + lane, RLX_AGENT);
                bias[(size_t)j * ldb + vrow0 + lane] = s; }
        }
    }
}
__device__ __forceinline__ int vcol_in(int n) {
    if (n < 5120 || n >= 7168) return n;
    const int isb = n >= 6144, c = n - (isb ? 6144 : 5120), t = c >> 7;
    return 5120 + t * 256 + isb * 128 + (c & 127);
}
enum { CV_HG = 1, CV_CV = 2, CV_OUT = 4, CV_DOWN = 8, CV_IN = 16  , CV_UP = 32, CV_IN2 = 64   };
__device__ __forceinline__ void convert_weights(const Frame& F, int l, int mask, int first_cu = 0) {
    LAS float* scr = (LAS float*)(F.lds + F.wave * 16384);
    if ((int)blockIdx.x < first_cu) return;
    const int gw = first_cu ? ((int)blockIdx.x - first_cu) * NWAVES + F.wave : F.vcu * NWAVES + F.wave, NGW = (F.G - first_cu) * NWAVES;
    bf16_t* Wb = (bf16_t*)(F.ws + WS_W);
    const float* modf = (const float*)(F.ws + WS_MOD) + (size_t)l * 3 * NMOD;
    constexpr int I_SQ = 16 * 32, I_DN = 44 * 32, I_IN1 = 16 * 128, I_IN2 = 16 * 160, I_UP = 16 * 176;
    const int n_hg = (mask & CV_HG) ? I_SQ : 0, n_cv = (mask & CV_CV) ? I_SQ : 0, n_out = (mask & CV_OUT) ? I_SQ : 0, n_dn = (mask & CV_DOWN) ? I_DN : 0,
              n_in1 = (mask & CV_IN) ? I_IN1 : 0, n_in = n_in1 + ((mask & CV_IN2) ? I_IN2 : 0), n_up = (mask & CV_UP) ? I_UP : 0;
    const int total = n_hg + n_cv + n_out + n_dn + n_in + n_up;
    for (int it = gw; it < total; it += NGW) {
        int r = it;
        if (r < n_in) {
            const int cb = (r + ((mask & CV_IN) ? 0 : I_IN1)) / 16, kb = r % 16, n0 = cb * 32, v0 = vcol_in(n0);
            transpose_item<true>(F.a->in[7] + (size_t)l * D * PIN, D, PIN, Wb + WO_IN / 2, kb, n0, v0, scr, F.lane, modf + 0 * D  , (float*)(F.ws + WS_BIASP), PIN);
            bias_finish((unsigned*)(F.ws + WS_CTL) + CW_CNT_IN + l * 288 + cb, (const float*)(F.ws + WS_BIASP), PIN, v0, (float*)(F.ws + WS_BIASIN) + (size_t)l * 3 * PIN, F.lane);
            continue; } r -= n_in;
        if (r < n_up) {
            const int cb = r / 16, kb = r % 16, n0 = cb * 32;
            transpose_item<true>(F.a->in[18] + (size_t)l * D * NUP, D, NUP, Wb + WO_UP / 2, kb, n0, n0, scr, F.lane, modf + 3 * D  , (float*)(F.ws + WS_BIASP2), NUP);
            bias_finish((unsigned*)(F.ws + WS_CTL) + CW_CNT_UP + l * 176 + cb, (const float*)(F.ws + WS_BIASP2), NUP, n0, (float*)(F.ws + WS_BIASUP) + (size_t)l * 3 * NUP, F.lane);
            continue; } r -= n_up;
        if (r < n_hg) { transpose_item<false>(F.a->in[10] + (size_t)l * D * D, D, D, Wb + WO_HG / 2, r / 32, (r % 32) * 32, (r % 32) * 32, scr, F.lane, nullptr, nullptr, 0); continue; } r -= n_hg;
        if (r < n_cv) { transpose_item<false>(F.a->in[15] + (size_t)l * D * D, D, D, Wb + WO_CV / 2, r / 32, (r % 32) * 32, (r % 32) * 32, scr, F.lane, nullptr, nullptr, 0); continue; } r -= n_cv;
        if (r < n_out) { transpose_item<false>(F.a->in[16] + (size_t)l * D * D, D, D, Wb + WO_OUT / 2, r / 32, (r % 32) * 32, (r % 32) * 32, scr, F.lane, nullptr, nullptr, 0); continue; } r -= n_out;
        transpose_item<false>(F.a->in[21] + (size_t)l * FFN * D, FFN, D, Wb + WO_DOWN / 2, r / 32, (r % 32) * 32, (r % 32) * 32, scr, F.lane, nullptr, nullptr, 0);
    }
}

__device__ __forceinline__ void mod_gemv(const Frame& F) {
    const int gw = F.vcu * NWAVES + F.wave, NGW = F.G * NWAVES, lane = F.lane;
    float* modp = (float*)(F.ws + WS_MODP); float* modf = (float*)(F.ws + WS_MOD);
    for (int it = gw; it < 2 * 24 * 16; it += NGW) {
        const int l = it / 384, r = it % 384, cg = r / 16, ks = r % 16, k0 = 64 * ks;
        const float c0 = F.a->in[1][k0 + lane], c1 = F.a->in[1][D + k0 + lane], c2 = F.a->in[3][k0 + lane];
        const float s0 = siluf_(c0), s1 = siluf_(c1), s2 = siluf_(c2);
        const float* Wp = F.a->in[4] + ((size_t)l * D + k0) * NMOD + cg * 256 + lane * 4;
        f32x4 a0 = {0.f, 0.f, 0.f, 0.f}, a1 = a0, a2 = a0;
#pragma unroll 16
        for (int kk = 0; kk < 64; ++kk) {
            const f32x4 w = *(const f32x4*)(Wp + (size_t)kk * NMOD);
            a0 += __shfl(s0, kk) * w; a1 += __shfl(s1, kk) * w; a2 += __shfl(s2, kk) * w;
        }
        const size_t po = ((size_t)(l * 16 + ks) * 3) * NMOD + cg * 256 + lane * 4;
#pragma unroll
        for (int q = 0; q < 4; ++q) { __hip_atomic_store(modp + po + q, a0[q], RLX_AGENT); __hip_atomic_store(modp + po + NMOD + q, a1[q], RLX_AGENT); __hip_atomic_store(modp + po + 2 * NMOD + q, a2[q], RLX_AGENT); }
        VM_WAIT();
        unsigned old = 0;
        if (lane == 0) old = __hip_atomic_fetch_add((unsigned*)(F.ws + WS_CTL) + CW_CNT_MOD + l * 24 + cg, 1u, RLX_AGENT);
        old = __builtin_amdgcn_readfirstlane(old);
        if ((old & 15u) == 15u) {
            const f32x4 bm = *(const f32x4*)(F.a->in[5] + (size_t)l * NMOD + cg * 256 + lane * 4);
#pragma unroll
            for (int j = 0; j < 3; ++j) { f32x4 s = bm;
                for (int k2 = 0; k2 < 16; ++k2) { const float* p = modp + ((size_t)(l * 16 + k2) * 3 + j) * NMOD + cg * 256 + lane * 4;
                    f32x4 v; v.x = __hip_atomic_load(p, RLX_AGENT); v.y = __hip_atomic_load(p + 1, RLX_AGENT); v.z = __hip_atomic_load(p + 2, RLX_AGENT); v.w = __hip_atomic_load(p + 3, RLX_AGENT); s += v; }
                *(f32x4*)(modf + ((size_t)l * 3 + j) * NMOD + cg * 256 + lane * 4) = s; }
        }
    }
}

__device__ __forceinline__ void xb_init(const Frame& F) {
    const int gw = F.vcu * NWAVES + F.wave, NGW = F.G * NWAVES, lane = F.lane;
    const float* modf = (const float*)(F.ws + WS_MOD);
    bf16_t* xb = (bf16_t*)(F.ws + WS_XB); float* ssq = (float*)(F.ws + WS_SSQ);
    f32x4 nx[4];
    auto load_row = [&](int row) {
        const float* src = row < ML ? F.a->in[0] + (size_t)row * D : F.a->in[2] + (size_t)(row - ML) * D;
#pragma unroll
        for (int q = 0; q < 4; ++q) nx[q] = *(const f32x4*)(src + 256 * q + 4 * lane);
    };
    if (gw < MT) load_row(gw);
    for (int row = gw; row < MT; row += NGW) {
        const int j = mod_index(row);
        f32x4 v[4];
#pragma unroll
        for (int q = 0; q < 4; ++q) v[q] = nx[q];
        if (row + NGW < MT) load_row(row + NGW);
        float s = 0.f;
#pragma unroll
        for (int q = 0; q < 4; ++q) {
            const int c = 256 * q + 4 * lane;
            s += (v[q].x * v[q].x + v[q].y * v[q].y) + (v[q].z * v[q].z + v[q].w * v[q].w);
            const f32x4 nw = *(const f32x4*)(F.a->in[6] + c), sc = *(const f32x4*)(modf + (size_t)j * NMOD + D + c);
            const f32x4 o = v[q] * nw * (sc + 1.0f);
            u32x2 w; w.x = pk2(o.x, o.y); w.y = pk2(o.z, o.w);
            *(u32x2*)(xb + (size_t)row * D + c) = w;
        }
        s = wave_sum(s);
        if (lane < 16) ssq[(size_t)row * 16 + lane] = lane == 0 ? s : 0.f;
    }
}

struct EpiCommon {
    __device__ static __forceinline__ float rstd_of(const float* ssq, int row) {
        const f32x4 a = *(const f32x4*)(ssq + (size_t)row * 16), b = *(const f32x4*)(ssq + (size_t)row * 16 + 4), c = *(const f32x4*)(ssq + (size_t)row * 16 + 8), d = *(const f32x4*)(ssq + (size_t)row * 16 + 12);
        const float s = ((a.x + a.y) + (a.z + a.w)) + ((b.x + b.y) + (b.z + b.w)) + ((c.x + c.y) + (c.z + c.w)) + ((d.x + d.y) + (d.z + d.w));
        return rsqrtf_(s * (1.0f / D) + EPS);
    }
    __device__ static __forceinline__ const LAS float* rstd_tile(const float* ssq, int row0, int wr, int wc, int fr, int fq) {
        LAS float* rsl = (LAS float*)((LAS unsigned char*)0 + pg8::STAGE_BYTES);
        const int tid = (wr * 4 + wc) * 64 + fq * 16 + fr;
        __builtin_amdgcn_s_barrier();
        if (tid < 256) rsl[tid] = rstd_of(ssq, row0 + tid);
        asm volatile("s_waitcnt lgkmcnt(0)" ::: "memory");
        __builtin_amdgcn_s_barrier();
        return rsl + wr * 64 + fr;
    }
};
struct EpiG1 {
    const float* ssq; const float* bias;
    bf16_t* QV; unsigned short* Ff; unsigned short* Fb;
    template <int NA, int NM> __device__ __forceinline__ void operator()(const f32x4 (&acc)[NA][2][NM][2], const pg8::Unit& u, int ro, int wr, int wc, int fr, int fq) const {
        const int j = u.pm < 32 ? 0 : (u.pm < 64 ? 1 : 2), type = u.pn >> 2;
        const int colt = u.pn * 256 + wc * 32 + 8 * fq;
        const LAS float* rsl = EpiCommon::rstd_tile(ssq, u.pm * 256, wr, wc, fr, fq);
        f32x4 bv[2][2];
#pragma unroll
        for (int bj = 0; bj < 2; ++bj)
#pragma unroll
            for (int n = 0; n < 2; ++n) bv[bj][n] = *(const f32x4*)(bias + (size_t)j * PIN + colt + bj * 128 + 4 * n);
#pragma unroll
        for (int ai = 0; ai < NA; ++ai)
#pragma unroll
            for (int m = 0; m < NM; ++m) {
                const int row = u.pm * 256 + ro + ai * 128 + wr * 64 + m * 16 + fr;
                const float rs = rsl[ro + ai * 128 + m * 16];
#pragma unroll
                for (int bj = 0; bj < 2; ++bj) {
                    const f32x4 v0 = acc[ai][bj][m][0] * rs + bv[bj][0], v1 = acc[ai][bj][m][1] * rs + bv[bj][1];
                    const int c = colt + bj * 128;
                    u32x4 w;
                    if (type == 1 || type == 2) {
                        f32x4 c0, c1;
                        c0.x = __builtin_amdgcn_rcpf(1.0f + __builtin_amdgcn_exp2f(v0.x * 1.4426950408889634f)); c0.y = __builtin_amdgcn_rcpf(1.0f + __builtin_amdgcn_exp2f(v0.y * 1.4426950408889634f));
                        c0.z = __builtin_amdgcn_rcpf(1.0f + __builtin_amdgcn_exp2f(v0.z * 1.4426950408889634f)); c0.w = __builtin_amdgcn_rcpf(1.0f + __builtin_amdgcn_exp2f(v0.w * 1.4426950408889634f));
                        c1.x = __builtin_amdgcn_rcpf(1.0f + __builtin_amdgcn_exp2f(v1.x * 1.4426950408889634f)); c1.y = __builtin_amdgcn_rcpf(1.0f + __builtin_amdgcn_exp2f(v1.y * 1.4426950408889634f));
                        c1.z = __builtin_amdgcn_rcpf(1.0f + __builtin_amdgcn_exp2f(v1.z * 1.4426950408889634f)); c1.w = __builtin_amdgcn_rcpf(1.0f + __builtin_amdgcn_exp2f(v1.w * 1.4426950408889634f));
                        w.x = pkh2(c0.x, c0.y); w.y = pkh2(c0.z, c0.w); w.z = pkh2(c1.x, c1.y); w.w = pkh2(c1.z, c1.w);
                        unsigned short* dst = (type == 1 ? Ff : Fb) + (size_t)row * D + (c - type * 1024);
                        *(u32x4*)dst = w;
                    } else {
                        w.x = pk2(v0.x, v0.y); w.y = pk2(v0.z, v0.w); w.z = pk2(v1.x, v1.y); w.w = pk2(v1.z, v1.w);
                        bf16_t* dst = QV + (size_t)row * 2048 + (type == 0 ? c : 1024 + (c - 3072));
                        *(u32x4*)dst = w;
                    }
                }
            }
    }
};
struct EpiG2 {
    const float* ssq; const float* bias;
    bf16_t* QV; bf16_t* U; bf16_t* SGH; bf16_t* SGC; bool dry;
    template <int NA, int NM> __device__ __forceinline__ void operator()(const f32x4 (&acc)[NA][2][NM][2], const pg8::Unit& u, int ro, int wr, int wc, int fr, int fq) const {
        const int j = u.pm < 32 ? 0 : (u.pm < 64 ? 1 : 2);
        const int colt = 4096 + u.pn * 256 + wc * 32 + 8 * fq;
        const LAS float* rsl = EpiCommon::rstd_tile(ssq, u.pm * 256, wr, wc, fr, fq);
        f32x4 bv[2][2];
#pragma unroll
        for (int bj = 0; bj < 2; ++bj)
#pragma unroll
            for (int n = 0; n < 2; ++n) bv[bj][n] = *(const f32x4*)(bias + (size_t)j * PIN + colt + bj * 128 + 4 * n);
#pragma unroll
        for (int ai = 0; ai < NA; ++ai)
#pragma unroll
            for (int m = 0; m < NM; ++m) {
                const int row = u.pm * 256 + ro + ai * 128 + wr * 64 + m * 16 + fr;
                const float rs = rsl[ro + ai * 128 + m * 16];
                f32x4 v[2][2];
#pragma unroll
                for (int bj = 0; bj < 2; ++bj) { v[bj][0] = acc[ai][bj][m][0] * rs + bv[bj][0]; v[bj][1] = acc[ai][bj][m][1] * rs + bv[bj][1]; }
                if (u.pn < 4) {
#pragma unroll
                    for (int bj = 0; bj < 2; ++bj) {
                        bf16_t* p = QV + (size_t)row * 2048 + (colt - 4096) + bj * 128;
                        const u32x4 on = *(const u32x4*)p;
                        u32x4 w;
                        w.x = pk2(bflo(on.x) * siluf_(v[bj][0].x), bfhi(on.x) * siluf_(v[bj][0].y)); w.y = pk2(bflo(on.y) * siluf_(v[bj][0].z), bfhi(on.y) * siluf_(v[bj][0].w));
                        w.z = pk2(bflo(on.z) * siluf_(v[bj][1].x), bfhi(on.z) * siluf_(v[bj][1].y)); w.w = pk2(bflo(on.w) * siluf_(v[bj][1].z), bfhi(on.w) * siluf_(v[bj][1].w));
                        if (!dry) *(u32x4*)p = w; else asm volatile("" :: "v"(w));
                    }
                } else if (u.pn < 12) {
                    const int t = u.pn - 4;
                    const f32x4 a0 = v[0][0], a1 = v[0][1], b0 = v[1][0], b1 = v[1][1];
                    u32x4 w;
                    w.x = pk2(a0.x * sigmoidf_(b0.x), a0.y * sigmoidf_(b0.y)); w.y = pk2(a0.z * sigmoidf_(b0.z), a0.w * sigmoidf_(b0.w));
                    w.z = pk2(a1.x * sigmoidf_(b1.x), a1.y * sigmoidf_(b1.y)); w.w = pk2(a1.z * sigmoidf_(b1.z), a1.w * sigmoidf_(b1.w));
                    *(u32x4*)(U + (size_t)row * D + t * 128 + wc * 32 + 8 * fq) = w;
                } else {
                    bf16_t* base = (u.pn < 16 ? SGH : SGC) + (size_t)row * D + ((u.pn & 3) * 256 + wc * 32 + 8 * fq);
#pragma unroll
                    for (int bj = 0; bj < 2; ++bj) {
                        u32x4 w;
                        w.x = pk2(sigmoidf_(v[bj][0].x), sigmoidf_(v[bj][0].y)); w.y = pk2(sigmoidf_(v[bj][0].z), sigmoidf_(v[bj][0].w));
                        w.z = pk2(sigmoidf_(v[bj][1].x), sigmoidf_(v[bj][1].y)); w.w = pk2(sigmoidf_(v[bj][1].z), sigmoidf_(v[bj][1].w));
                        *(u32x4*)(base + bj * 128) = w;
                    }
                }
            }
    }
};
template <int PASS> struct EpiY {
    const bf16_t* SG; bf16_t* Y; const bf16_t* T;
    template <int NA, int NM> __device__ __forceinline__ void operator()(const f32x4 (&acc)[NA][2][NM][2], const pg8::Unit& u, int ro, int wr, int wc, int fr, int fq) const {
        const int colt = u.pn * 256 + wc * 32 + 8 * fq;
#pragma unroll
        for (int ai = 0; ai < NA; ++ai) {
#pragma unroll
            for (int mp = 0; mp < NM; mp += 2) {
            u32x4 g[4][2], t[4][2];
#pragma unroll
            for (int m = mp; m < (NM < 2 ? NM : mp + 2); ++m)
#pragma unroll
                for (int bj = 0; bj < 2; ++bj) {
                    const size_t o = (size_t)(u.pm * 256 + ro + ai * 128 + wr * 64 + m * 16 + fr) * D + colt + bj * 128;
                    g[m][bj] = *(const u32x4*)(SG + o);
                    if (PASS == 2) t[m][bj] = *(const u32x4*)(T + o);
                }
#pragma unroll
            for (int m = mp; m < (NM < 2 ? NM : mp + 2); ++m)
#pragma unroll
                for (int bj = 0; bj < 2; ++bj) {
                    const size_t o = (size_t)(u.pm * 256 + ro + ai * 128 + wr * 64 + m * 16 + fr) * D + colt + bj * 128;
                    const u32x4 gg = g[m][bj];
                    f32x4 v0 = acc[ai][bj][m][0], v1 = acc[ai][bj][m][1];
                    v0.x *= bflo(gg.x); v0.y *= bfhi(gg.x); v0.z *= bflo(gg.y); v0.w *= bfhi(gg.y);
                    v1.x *= bflo(gg.z); v1.y *= bfhi(gg.z); v1.z *= bflo(gg.w); v1.w *= bfhi(gg.w);
                    if (PASS == 2) { const u32x4 tt = t[m][bj];
                        v0.x += bflo(tt.x); v0.y += bfhi(tt.x); v0.z += bflo(tt.y); v0.w += bfhi(tt.y);
                        v1.x += bflo(tt.z); v1.y += bfhi(tt.z); v1.z += bflo(tt.w); v1.w += bfhi(tt.w); }
                    u32x4 w; w.x = pk2(v0.x, v0.y); w.y = pk2(v0.z, v0.w); w.z = pk2(v1.x, v1.y); w.w = pk2(v1.z, v1.w);
                    *(u32x4*)(Y + o) = w;
                }
            }
        }
    }
};
struct EpiRes {
    const float* slat; const float* sctx;
    float* xlat; float* xctx; const float* gate  ; const float* nw  ; const float* nsc  ;
    bf16_t* xb; float* ssq; bool dry;
    template <int NA, int NM> __device__ __forceinline__ void operator()(const f32x4 (&acc)[NA][2][NM][2], const pg8::Unit& u, int ro, int wr, int wc, int fr, int fq) const {
        const int j = u.pm < 32 ? 0 : (u.pm < 64 ? 1 : 2);
        const int colt = u.pn * 256 + wc * 32 + 8 * fq;
        LAS f32x4* cs = (LAS f32x4*)((LAS unsigned char*)0 + pg8::STAGE_BYTES) + ((wr * 4 + wc) * 4 + fq) * 8;
#pragma unroll
        for (int bj = 0; bj < 2; ++bj)
#pragma unroll
            for (int n = 0; n < 2; ++n) {
                const f32x4 gvv = *(const f32x4*)(gate + (size_t)j * NMOD + colt + bj * 128 + 4 * n);
                f32x4 svv = (f32x4){0.f, 0.f, 0.f, 0.f};
                if (nw) svv = *(const f32x4*)(nw + colt + bj * 128 + 4 * n) * (*(const f32x4*)(nsc + (size_t)j * NMOD + colt + bj * 128 + 4 * n) + 1.0f);
                if (fr == 0) { cs[bj * 2 + n] = gvv; cs[4 + bj * 2 + n] = svv; }
            }
#pragma unroll
        for (int ai = 0; ai < NA; ++ai)
#pragma unroll
            for (int mp = 0; mp < NM; mp += 2) {
                constexpr int MB = NM < 2 ? NM : 2;
                f32x4 xv[MB][2][2];
#pragma unroll
                for (int mi = 0; mi < MB; ++mi) {
                    const int row = u.pm * 256 + ro + ai * 128 + wr * 64 + (mp + mi) * 16 + fr;
                    const float* xs = (row < ML ? slat + (size_t)row * D : sctx + (size_t)(row - ML) * D) + colt;
#pragma unroll
                    for (int bj = 0; bj < 2; ++bj) { xv[mi][bj][0] = *(const f32x4*)(xs + bj * 128); xv[mi][bj][1] = *(const f32x4*)(xs + bj * 128 + 4); }
                }
                asm volatile("" ::: "memory");
#pragma unroll
                for (int mi = 0; mi < MB; ++mi) {
                    const int m = mp + mi;
                    const int row = u.pm * 256 + ro + ai * 128 + wr * 64 + m * 16 + fr;
                    float* xr = (row < ML ? xlat + (size_t)row * D : xctx + (size_t)(row - ML) * D) + colt;
                    float s = 0.f;
#pragma unroll
                    for (int bj = 0; bj < 2; ++bj) {
                        f32x4 x0 = xv[mi][bj][0], x1 = xv[mi][bj][1];
                        x0 += cs[bj * 2] * acc[ai][bj][m][0]; x1 += cs[bj * 2 + 1] * acc[ai][bj][m][1];
                        if (!dry) { *(f32x4*)(xr + bj * 128) = x0; *(f32x4*)(xr + bj * 128 + 4) = x1; }
                        s += ((x0.x * x0.x + x0.y * x0.y) + (x0.z * x0.z + x0.w * x0.w)) + ((x1.x * x1.x + x1.y * x1.y) + (x1.z * x1.z + x1.w * x1.w));
                        if (nw) { const f32x4 o0 = x0 * cs[4 + bj * 2], o1 = x1 * cs[4 + bj * 2 + 1];
                            u32x4 w; w.x = pk2(o0.x, o0.y); w.y = pk2(o0.z, o0.w); w.z = pk2(o1.x, o1.y); w.w = pk2(o1.z, o1.w);
                            if (!dry) *(u32x4*)(xb + (size_t)row * D + colt + bj * 128) = w; else asm volatile("" :: "v"(w)); }
                    }
                    s += __shfl_xor(s, 16); s += __shfl_xor(s, 32);
                    if (fq == 0 && !dry) ssq[(size_t)row * 16 + u.pn * 4 + wc] = s;
                }
            }
    }
};
struct EpiFinal {
    float* xio; const float* gate  ; const float* fnw; float* ssq; unsigned* cnt  ;
    __device__ __forceinline__ void operator()(f32x4 (&acc)[2][2][4][2], const pg8::Unit& u, int  , int wr, int wc, int fr, int fq) const {
        const int j = u.pm < 32 ? 0 : 1;
        const int colt = u.pn * 256 + wc * 32 + 8 * fq;
        f32x4 gv[2][2];
#pragma unroll
        for (int bj = 0; bj < 2; ++bj)
#pragma unroll
            for (int n = 0; n < 2; ++n) gv[bj][n] = *(const f32x4*)(gate + (size_t)j * NMOD + colt + bj * 128 + 4 * n);
#pragma unroll
        for (int ai = 0; ai < 2; ++ai)
#pragma unroll
            for (int m = 0; m < 4; ++m) {
                const int row = u.pm * 256 + ai * 128 + wr * 64 + m * 16 + fr;
                const float* xr = xio + (size_t)row * D + colt;
                float sq = 0.f;
#pragma unroll
                for (int bj = 0; bj < 2; ++bj) {
                    const f32x4 x0 = *(const f32x4*)(xr + bj * 128) + gv[bj][0] * acc[ai][bj][m][0], x1 = *(const f32x4*)(xr + bj * 128 + 4) + gv[bj][1] * acc[ai][bj][m][1];
                    acc[ai][bj][m][0] = x0; acc[ai][bj][m][1] = x1;
                    sq += ((x0.x * x0.x + x0.y * x0.y) + (x0.z * x0.z + x0.w * x0.w)) + ((x1.x * x1.x + x1.y * x1.y) + (x1.z * x1.z + x1.w * x1.w));
                }
                sq += __shfl_xor(sq, 16); sq += __shfl_xor(sq, 32);
                if (fq == 0) __hip_atomic_store(ssq + (size_t)row * 16 + u.pn * 4 + wc, sq, RLX_AGENT);
            }
        VM_WAIT();
        unsigned* c = cnt + 64 * u.pm;
        if ((threadIdx.x & 63) == 0) __hip_atomic_fetch_add(c, 1u, RLX_AGENT);
        {   unsigned spins = 0;
            while ((unsigned)__builtin_amdgcn_readfirstlane(__hip_atomic_load(c, RLX_AGENT)) < 32u && ++spins < (1u << 22)) __builtin_amdgcn_s_sleep(2);
        }
        __builtin_amdgcn_fence(__ATOMIC_ACQUIRE, "agent");
        VM_WAIT();
        f32x4 wv[2][2];
#pragma unroll
        for (int bj = 0; bj < 2; ++bj)
#pragma unroll
            for (int n = 0; n < 2; ++n) wv[bj][n] = *(const f32x4*)(fnw + colt + bj * 128 + 4 * n);
#pragma unroll
        for (int ai = 0; ai < 2; ++ai)
#pragma unroll
            for (int m = 0; m < 4; ++m) {
                const int row = u.pm * 256 + ai * 128 + wr * 64 + m * 16 + fr;
                const float rs = EpiCommon::rstd_of(ssq, row);
                float* xr = xio + (size_t)row * D + colt;
#pragma unroll
                for (int bj = 0; bj < 2; ++bj) { *(f32x4*)(xr + bj * 128) = acc[ai][bj][m][0] * rs * wv[bj][0]; *(f32x4*)(xr + bj * 128 + 4) = acc[ai][bj][m][1] * rs * wv[bj][1]; }
            }
    }
};
struct EpiUp {
    const float* ssq; const float* bias;
    bf16_t* UV;
    template <int NA, int NM> __device__ __forceinline__ void operator()(const f32x4 (&acc)[NA][2][NM][2], const pg8::Unit& u, int ro, int wr, int wc, int fr, int fq) const {
        const int j = u.pm < 32 ? 0 : (u.pm < 64 ? 1 : 2);
        const int colt = u.pn * 256 + wc * 32 + 8 * fq;
        const LAS float* rsl = EpiCommon::rstd_tile(ssq, u.pm * 256, wr, wc, fr, fq);
        f32x4 bv[2][2];
#pragma unroll
        for (int bj = 0; bj < 2; ++bj)
#pragma unroll
            for (int n = 0; n < 2; ++n) bv[bj][n] = *(const f32x4*)(bias + (size_t)j * NUP + colt + bj * 128 + 4 * n);
#pragma unroll
        for (int ai = 0; ai < NA; ++ai)
#pragma unroll
            for (int m = 0; m < NM; ++m) {
                const int row = u.pm * 256 + ro + ai * 128 + wr * 64 + m * 16 + fr;
                const float rs = rsl[ro + ai * 128 + m * 16];
#pragma unroll
                for (int bj = 0; bj < 2; ++bj) {
                    const f32x4 v0 = acc[ai][bj][m][0] * rs + bv[bj][0], v1 = acc[ai][bj][m][1] * rs + bv[bj][1];
                    u32x4 w; w.x = pk2(v0.x, v0.y); w.y = pk2(v0.z, v0.w); w.z = pk2(v1.x, v1.y); w.w = pk2(v1.z, v1.w);
                    *(u32x4*)(UV + (size_t)row * NUP + colt + bj * 128) = w;
                }
            }
    }
};

namespace hg {
constexpr int S128 = 272, S64 = 144;
constexpr int O_QH = 0, O_KH = O_QH + 64 * S128, O_KE = O_KH + 64 * S128, O_VT = O_KE + 128 * S64, O_ST = O_VT + 128 * S64, O_P = O_ST + 128 * S128,
              O_SEG = O_P + 64 * S64, O_CE = O_SEG + 8 * 128 * 4, O_EM = O_CE + 128 * 4, O_RMS = O_EM + 128 * 4, O_END = O_RMS + 64 * 4 * 4;
static_assert(O_END <= 131072, "hgrn lds");
constexpr float LOG2E = 1.4426950408889634f;
__device__ __forceinline__ float lb_of(const Frame& F, int l, int dir, int ch) {
    if (l == 0) return 0.f;
    const float x0 = F.a->in[8][(size_t)(dir * DEPTH + 0) * D + ch], x1 = F.a->in[8][(size_t)(dir * DEPTH + 1) * D + ch];
    return sigmoidf_(x1 - x0);
}
typedef _Float16 h2_t __attribute__((ext_vector_type(2)));
__device__ __forceinline__ __amdgpu_buffer_rsrc_t mk_rsrc(const void* p) { return __builtin_amdgcn_make_buffer_rsrc((void*)p, 0, 0x7ffffff0, 0x00020000); }
__device__ __forceinline__ void load8(unsigned (&dst)[8], __amdgpu_buffer_rsrc_t rs, unsigned lane_off_bytes, unsigned row0_off_bytes, unsigned stride_bytes) {
#pragma unroll
    for (int i = 0; i < 8; ++i) dst[i] = (unsigned)__builtin_amdgcn_raw_buffer_load_b32(rs, lane_off_bytes, row0_off_bytes + (unsigned)i * stride_bytes, 0);
}
__device__ __forceinline__ f32x2 ex2(f32x2 v) { return (f32x2){__builtin_amdgcn_exp2f(v.x), __builtin_amdgcn_exp2f(v.y)}; }
__device__ __forceinline__ f32x2 gates8(const unsigned (&rf)[8], f32x2 lb, f32x2 (&gg)[8], unsigned (&kk)[8]) {
    const f32x2 oml = 1.0f - lb;
#pragma unroll
    for (int i = 0; i < 8; ++i) {
        const f32x2 c = __builtin_convertvector(__builtin_bit_cast(h2_t, rf[i]), f32x2);
        const f32x2 kv = oml * c;
        f32x2 g = 1.0f - kv; g.x = fmaxf(g.x, GMIN); g.y = fmaxf(g.y, GMIN);
        gg[i] = g;
        kk[i] = pk2(kv.x, kv.y);
    }
    const f32x2 p0 = (gg[0] * gg[1]) * (gg[2] * gg[3]), p1 = (gg[4] * gg[5]) * (gg[6] * gg[7]);
    return (f32x2){__builtin_amdgcn_logf(p0.x) + __builtin_amdgcn_logf(p1.x), __builtin_amdgcn_logf(p0.y) + __builtin_amdgcn_logf(p1.y)};
}
template <int DIR>
__device__ __forceinline__ void decay8(const Frame& F, f32x2 tot, f32x2 (&gg)[8], f32x2 (&ke)[8], f32x2& cmid, f32x2& cend) {
    LAS f32x2* seg = (LAS f32x2*)(F.lds + O_SEG);
    const int w = F.wave;
    seg[w * 64 + F.lane] = tot;
    __syncthreads();
    f32x2 sv[8];
#pragma unroll
    for (int k = 0; k < 8; ++k) sv[k] = seg[k * 64 + F.lane];
    const f32x2 lo4 = (sv[0] + sv[1]) + (sv[2] + sv[3]), hi4 = (sv[4] + sv[5]) + (sv[6] + sv[7]);
    cend = lo4 + hi4; cmid = DIR == 0 ? lo4 : hi4;
    f32x2 before = {0.f, 0.f}, after = {0.f, 0.f};
#pragma unroll
    for (int k = 0; k < 8; ++k) { before += (k < w) ? sv[k] : (f32x2){0.f, 0.f}; after += (k > w) ? sv[k] : (f32x2){0.f, 0.f}; }
    const f32x2 off = DIR == 0 ? before : after, outer = DIR == 0 ? after : before;
    const f32x2 a0 = off - cmid;
    f32x2 e = ex2((f32x2){fminf(a0.x, 100.f), fminf(a0.y, 100.f)}), k = ex2(outer);
    if (DIR == 0) {
        ke[7] = k;
#pragma unroll
        for (int i = 6; i >= 0; --i) { k *= gg[i + 1]; ke[i] = k; }
#pragma unroll
        for (int i = 0; i < 8; ++i) { e *= gg[i]; gg[i] = e; }
    } else {
        ke[0] = k;
#pragma unroll
        for (int i = 1; i < 8; ++i) { k *= gg[i - 1]; ke[i] = k; }
#pragma unroll
        for (int i = 7; i >= 0; --i) { e *= gg[i]; gg[i] = e; }
    }
}
__device__ __forceinline__ void write_ke_vt8(const Frame& F, const f32x2 (&kef)[8], const unsigned (&kk)[8], const unsigned (&rv)[8], f32x2 cend) {
    LAS unsigned char* L = F.lds;
    const int w = F.wave;
    f32x2 ke[8];
#pragma unroll
    for (int i = 0; i < 8; ++i) ke[i] = (f32x2){bflo(kk[i]), bfhi(kk[i])} * kef[i];
    LAS unsigned char* kp = L + (2 * F.lane) * S64 + w * 16;
    *(LAS u32x4*)(kp + O_KE) = (u32x4){pk2(ke[0].x, ke[1].x), pk2(ke[2].x, ke[3].x), pk2(ke[4].x, ke[5].x), pk2(ke[6].x, ke[7].x)};
    *(LAS u32x4*)(kp + O_KE + S64) = (u32x4){pk2(ke[0].y, ke[1].y), pk2(ke[2].y, ke[3].y), pk2(ke[4].y, ke[5].y), pk2(ke[6].y, ke[7].y)};
    *(LAS u32x4*)(kp + O_VT) = (u32x4){__builtin_amdgcn_perm(rv[1], rv[0], 0x05040100u), __builtin_amdgcn_perm(rv[3], rv[2], 0x05040100u), __builtin_amdgcn_perm(rv[5], rv[4], 0x05040100u), __builtin_amdgcn_perm(rv[7], rv[6], 0x05040100u)};
    *(LAS u32x4*)(kp + O_VT + S64) = (u32x4){__builtin_amdgcn_perm(rv[1], rv[0], 0x07060302u), __builtin_amdgcn_perm(rv[3], rv[2], 0x07060302u), __builtin_amdgcn_perm(rv[5], rv[4], 0x07060302u), __builtin_amdgcn_perm(rv[7], rv[6], 0x07060302u)};
    if (w == 0) ((LAS f32x2*)(L + O_CE))[F.lane] = ex2(cend);
}
__device__ __forceinline__ void write_qh_kh8(const Frame& F, const f32x2 (&e1v)[8], const unsigned (&kk)[8], const unsigned (&rq)[8], f32x2 cmid) {
    LAS unsigned char* L = F.lds;
    const int w = F.wave;
    LAS unsigned char* tp = L + (8 * w) * S128 + F.lane * 4;
#pragma unroll
    for (int i = 0; i < 8; ++i) {
        const f32x2 e1 = e1v[i];
        const f32x2 e2 = {__builtin_amdgcn_rcpf(fmaxf(e1.x, 7.888609e-31f)), __builtin_amdgcn_rcpf(fmaxf(e1.y, 7.888609e-31f))};
        const f32x2 qh = (f32x2){bflo(rq[i]), bfhi(rq[i])} * e1, kh = (f32x2){bflo(kk[i]), bfhi(kk[i])} * e2;
        *(LAS unsigned*)(tp + O_QH + i * S128) = pk2(qh.x, qh.y);
        *(LAS unsigned*)(tp + O_KH + i * S128) = pk2(kh.x, kh.y);
    }
    if (w == 1) ((LAS f32x2*)(L + O_EM))[F.lane] = ex2(cmid);
}
__device__ __forceinline__ void state_update(const Frame& F, f32x16 (&S)[2]) {
    LAS unsigned char* L = F.lds;
    const int w = F.wave, lane = F.lane, r = lane & 31, hh = lane >> 5, db = w >> 1;
    const LAS float* ce = (const LAS float*)(L + O_CE) + 32 * db + 4 * hh;
    float dec[16];
#pragma unroll
    for (int g = 0; g < 4; ++g) { const f32x4 t = *(const LAS f32x4*)(ce + 8 * g); dec[4 * g] = t.x; dec[4 * g + 1] = t.y; dec[4 * g + 2] = t.z; dec[4 * g + 3] = t.w; }
    const LAS unsigned char* ap = L + O_KE + (32 * db + r) * S64 + 16 * hh;
#pragma unroll
    for (int blk = 0; blk < 2; ++blk) {
        const int eb = 2 * (w & 1) + blk;
        const LAS unsigned char* bp = L + O_VT + (32 * eb + r) * S64 + 16 * hh;
#pragma unroll
        for (int i = 0; i < 16; ++i) S[blk][i] *= dec[i];
#pragma unroll
        for (int kq = 0; kq < 4; ++kq) {
            const bf16x8 a = *(const LAS bf16x8*)(ap + 32 * kq);
            const bf16x8 b = *(const LAS bf16x8*)(bp + 32 * kq);
            S[blk] = __builtin_amdgcn_mfma_f32_32x32x16_bf16(a, b, S[blk], 0, 0, 0);
        }
    }
}
__device__ __forceinline__ void write_st(const Frame& F, const f32x16 (&S)[2]) {
    LAS unsigned char* L = F.lds;
    const int w = F.wave, lane = F.lane, r = lane & 31, hh = lane >> 5, db = w >> 1;
    const LAS float* em = (const LAS float*)(L + O_EM) + 32 * db + 4 * hh;
    f32x4 sc[4];
#pragma unroll
    for (int g = 0; g < 4; ++g) sc[g] = *(const LAS f32x4*)(em + 8 * g);
#pragma unroll
    for (int blk = 0; blk < 2; ++blk) {
        const int eb = 2 * (w & 1) + blk;
        LAS unsigned char* sp = L + O_ST + (32 * eb + r) * S128 + (32 * db + 4 * hh) * 2;
#pragma unroll
        for (int g = 0; g < 4; ++g) {
            u32x2 o; o.x = pk2(S[blk][4 * g] * sc[g].x, S[blk][4 * g + 1] * sc[g].y); o.y = pk2(S[blk][4 * g + 2] * sc[g].z, S[blk][4 * g + 3] * sc[g].w);
            *(LAS u32x2*)(sp + 16 * g) = o;
        }
    }
}
}

__device__ __forceinline__ void state_store(const Frame& F, float* base  , const f32x16 (&S)[2]) {
    const int w = F.wave, lane = F.lane, r = lane & 31, hh = lane >> 5, db = w >> 1;
    unsigned* ub = (unsigned*)base + (size_t)(16 * db + 2 * hh) * 128 + r;
#pragma unroll
    for (int blk = 0; blk < 2; ++blk) { unsigned* bp = ub + 32 * (2 * (w & 1) + blk);
#pragma unroll
        for (int g = 0; g < 4; ++g) { bp[(4 * g) * 128] = pk2(S[blk][4 * g], S[blk][4 * g + 1]); bp[(4 * g + 1) * 128] = pk2(S[blk][4 * g + 2], S[blk][4 * g + 3]); } }
}
__device__ __forceinline__ void state_load(const Frame& F, const float* base, f32x16 (&S)[2]) {
    const int w = F.wave, lane = F.lane, r = lane & 31, hh = lane >> 5, db = w >> 1;
    const unsigned* ub = (const unsigned*)base + (size_t)(16 * db + 2 * hh) * 128 + r;
#pragma unroll
    for (int blk = 0; blk < 2; ++blk) { const unsigned* bp = ub + 32 * (2 * (w & 1) + blk);
#pragma unroll
        for (int g = 0; g < 4; ++g) { const unsigned w0 = bp[(4 * g) * 128], w1 = bp[(4 * g + 1) * 128];
            S[blk][4 * g] = bflo(w0); S[blk][4 * g + 1] = bfhi(w0); S[blk][4 * g + 2] = bflo(w1); S[blk][4 * g + 3] = bfhi(w1); } }
}

__device__ __forceinline__ void hgrn_a_decode(int it, int& h, int& dir, int& row0) {
    if (it < 1024) { const int j = it & 31; dir = (it >> 5) & 1; h = (it >> 6) & 7; const int b = it >> 9; row0 = b * SEQ + 256 * j; }
    else { const int q = it - 1024; dir = q & 1; h = (q >> 1) & 7; const int b = q >> 4; row0 = ML + b * CTXL; }
}
__device__ __forceinline__ void hgrn_c_decode(int it, int& h, int& row0) {
    if (it < 512) { h = (it >> 5) & 7; row0 = (it >> 8) * SEQ + 256 * (it & 31); } else { const int q = it - 512; h = q & 7; row0 = ML + (q >> 3) * CTXL; }
}
template <int DIR>
__device__ __forceinline__ void hgrn_a_item(const Frame& F, int l, int it, int h, int row0, unsigned (&rf)[8], unsigned (&rv)[8], bool pre, int itn  ) {
    const bf16_t* QV = (const bf16_t*)(F.ws + WS_QV);
    float* ST = (float*)(F.ws + WS_ST); float* DV = (float*)(F.ws + WS_DV);
    const unsigned short* Fg = (const unsigned short*)(F.ws + (DIR == 0 ? WS_S2 : WS_S3));
    const int w = F.wave;
    const f32x2 lb = {hg::lb_of(F, l, DIR, h * 128 + 2 * F.lane), hg::lb_of(F, l, DIR, h * 128 + 2 * F.lane + 1)};
    f32x16 S[2];
#pragma unroll
    for (int i = 0; i < 16; ++i) { S[0][i] = 0.f; S[1][i] = 0.f; }
    f32x2 ctot = {0.f, 0.f};
    const __amdgpu_buffer_rsrc_t rsF = hg::mk_rsrc(Fg), rsQ = hg::mk_rsrc(QV);
    const unsigned lof = (unsigned)(h * 256 + F.lane * 4);
    if (!pre) { const int rowc = row0 + 64 * (DIR == 0 ? 0 : 3) + 8 * w;
      hg::load8(rf, rsF, lof, (unsigned)rowc * 2048u, 2048u); hg::load8(rv, rsQ, lof + 2048u, (unsigned)rowc * 4096u, 4096u); }
#pragma unroll 1
    for (int cc = 0; cc < 4; ++cc) {
        int rown = row0 + 64 * (DIR == 0 ? (cc < 3 ? cc + 1 : 3) : (cc < 3 ? 2 - cc : 0)) + 8 * w;
        const unsigned short* Fx = Fg; int hx = h;
        if (cc == 3 && itn >= 0) { int nd, nr; hgrn_a_decode(itn, hx, nd, nr); rown = nr + (nd ? 192 : 0) + 8 * w; Fx = (const unsigned short*)(F.ws + (nd ? WS_S3 : WS_S2)); }
        asm volatile("" : "+s"(rown));
        const __amdgpu_buffer_rsrc_t rsFx = hg::mk_rsrc(Fx);
        const unsigned lofx = (unsigned)(hx * 256 + F.lane * 4);
        f32x2 lg[8]; unsigned kk[8];
        const f32x2 tot = hg::gates8(rf, lb, lg, kk);
        hg::load8(rf, rsFx, lofx, (unsigned)rown * 2048u, 2048u);
        f32x2 cmid, cend;
        f32x2 kef[8];
        hg::decay8<DIR>(F, tot, lg, kef, cmid, cend);
        hg::write_ke_vt8(F, kef, kk, rv, cend);
        hg::load8(rv, rsQ, lofx + 2048u, (unsigned)rown * 4096u, 4096u);
        ctot += cend;
        __syncthreads();
        hg::state_update(F, S);
    }
    state_store(F, ST + (size_t)it * 16384, S);
    if (w == 0) ((f32x2*)(DV + (size_t)it * 128))[F.lane] = hg::ex2(ctot);
}
__device__ __forceinline__ void hgrn_phase_a(const Frame& F, int l, int ncu) {
    if ((int)blockIdx.x >= ncu) return;
    unsigned rf[8] = {}, rv[8] = {}; bool pre = false;
    for (int it = blockIdx.x; it < 1056; it += ncu) {
        int h, dir, row0; hgrn_a_decode(it, h, dir, row0);
        const int itn = it + ncu < 1056 ? it + ncu : -1;
        if (dir == 0) hgrn_a_item<0>(F, l, it, h, row0, rf, rv, pre, itn); else hgrn_a_item<1>(F, l, it, h, row0, rf, rv, pre, itn);
        pre = itn >= 0;
        __syncthreads();
    }
}
__device__ __forceinline__ void hgrn_scan(const Frame& F, bool dry) {
    unsigned* ST = (unsigned*)(F.ws + WS_ST); const float* DV = (const float*)(F.ws + WS_DV);
    const int nthreads = F.G * NTHR;
    for (int id = blockIdx.x * NTHR + F.tid; id < 32 * 64 * 32; id += nthreads) {
        const int e4 = id & 31, dp = (id >> 5) & 63, s = id >> 11;
        const int dir = s & 1;
        const u32x4 c0 = *(const u32x4*)(ST + (size_t)(1024 + s) * 16384 + dp * 128 + 4 * e4);
        f32x4 Sa = {bflo(c0.x), bflo(c0.y), bflo(c0.z), bflo(c0.w)}, Sb = {bfhi(c0.x), bfhi(c0.y), bfhi(c0.z), bfhi(c0.w)};
#pragma unroll 4
        for (int jj = 0; jj < 32; ++jj) {
            const int j = dir == 0 ? jj : 31 - jj, it = s * 32 + j;
            u32x4* p = (u32x4*)(ST + (size_t)it * 16384 + dp * 128 + 4 * e4);
            const u32x4 u = *p; const f32x2 dv = *(const f32x2*)(DV + (size_t)it * 128 + 2 * dp);
            if (!dry) *p = (u32x4){pk2(Sa.x, Sb.x), pk2(Sa.y, Sb.y), pk2(Sa.z, Sb.z), pk2(Sa.w, Sb.w)};
            Sa = Sa * dv.x + (f32x4){bflo(u.x), bflo(u.y), bflo(u.z), bflo(u.w)};
            Sb = Sb * dv.y + (f32x4){bfhi(u.x), bfhi(u.y), bfhi(u.z), bfhi(u.w)};
        }
    }
}
template <int DIR>
__device__ __forceinline__ void hgrn_c_dir(const Frame& F, int l, int it_lat  , int h, int row0, bf16_t* QV, unsigned* ofs  , bool dry,
                                           unsigned (&rf)[8], unsigned (&rq)[8], unsigned (&rv)[8], bool pre, int itn  ) {
    LAS unsigned char* L = F.lds;
    const int w = F.wave, lane = F.lane, tb = w >> 2, ebo = w & 3;
    const unsigned short* Fg = (const unsigned short*)(F.ws + (DIR == 0 ? WS_S2 : WS_S3));
    const f32x2 lb = {hg::lb_of(F, l, DIR, h * 128 + 2 * lane), hg::lb_of(F, l, DIR, h * 128 + 2 * lane + 1)};
    const float* ST = (const float*)(F.ws + WS_ST);
    f32x16 S[2];
    if (it_lat >= 0) state_load(F, ST + (size_t)(((it_lat >> 5) * 2 + DIR) * 32 + (it_lat & 31)) * 16384, S);
    else {
#pragma unroll
        for (int i = 0; i < 16; ++i) { S[0][i] = 0.f; S[1][i] = 0.f; }
    }
    const __amdgpu_buffer_rsrc_t rsF = hg::mk_rsrc(Fg), rsQ = hg::mk_rsrc(QV);
    const unsigned lof = (unsigned)(h * 256 + lane * 4);
    if (!pre) { const int rowc = row0 + 64 * (DIR == 0 ? 0 : 3) + 8 * w;
      hg::load8(rf, rsF, lof, (unsigned)rowc * 2048u, 2048u);
      hg::load8(rv, rsQ, lof + 2048u, (unsigned)rowc * 4096u, 4096u); hg::load8(rq, rsQ, lof, (unsigned)rowc * 4096u, 4096u); }
#pragma unroll 1
    for (int cc = 0; cc < 4; ++cc) {
        const int ch = DIR == 0 ? cc : 3 - cc, chn = DIR == 0 ? (cc < 3 ? cc + 1 : 3) : (cc < 3 ? 2 - cc : 0);
        int rowc = row0 + 64 * ch, rown = row0 + 64 * chn + 8 * w, r = lane & 31, hh = lane >> 5;
        const unsigned short* Fx = Fg; int hx = h;
        if (cc == 3) {
            if (DIR == 0) { rown = row0 + 192 + 8 * w; Fx = (const unsigned short*)(F.ws + WS_S3); }
            else if (itn >= 0) { int nr; hgrn_c_decode(itn, hx, nr); rown = nr + 8 * w; Fx = (const unsigned short*)(F.ws + WS_S2); }
        }
        asm volatile("" : "+s"(rowc), "+s"(rown));
        asm volatile("" : "+v"(r), "+v"(hh));
        const __amdgpu_buffer_rsrc_t rsFx = hg::mk_rsrc(Fx);
        const unsigned lofx = (unsigned)(hx * 256 + lane * 4);
        f32x2 lg[8]; unsigned kk[8];
        const f32x2 tot = hg::gates8(rf, lb, lg, kk);
        hg::load8(rf, rsFx, lofx, (unsigned)rown * 2048u, 2048u);
        f32x2 cmid, cend;
        f32x2 kef[8];
        hg::decay8<DIR>(F, tot, lg, kef, cmid, cend);
        hg::write_ke_vt8(F, kef, kk, rv, cend);
        hg::load8(rv, rsQ, lofx + 2048u, (unsigned)rown * 4096u, 4096u);
        hg::write_qh_kh8(F, lg, kk, rq, cmid);
        hg::load8(rq, rsQ, lofx, (unsigned)rown * 4096u, 4096u);
        __syncthreads();
        hg::write_st(F, S);
        if (w < 4) {
            const int sb = w >> 1, tbk = w & 1;
            const bool dead = DIR == 0 ? (sb == 1 && tbk == 0) : (sb == 0 && tbk == 1);
            f32x16 P;
#pragma unroll
            for (int i = 0; i < 16; ++i) P[i] = 0.f;
            if (!dead) {
                const LAS unsigned char* ap = L + hg::O_KH + (32 * sb + r) * hg::S128 + 16 * hh;
                const LAS unsigned char* bp = L + hg::O_QH + (32 * tbk + r) * hg::S128 + 16 * hh;
#pragma unroll
                for (int kq = 0; kq < 8; ++kq) {
                    const bf16x8 a = *(const LAS bf16x8*)(ap + 32 * kq);
                    const bf16x8 bb = *(const LAS bf16x8*)(bp + 32 * kq);
                    P = __builtin_amdgcn_mfma_f32_32x32x16_bf16(a, bb, P, 0, 0, 0);
                }
            }
            const int rel = 32 * (tbk - sb) + r - 4 * hh;
            LAS unsigned char* pp = L + hg::O_P + (32 * tbk + r) * hg::S64 + (32 * sb + 4 * hh) * 2;
#pragma unroll
            for (int g = 0; g < 4; ++g) {
                float v0 = P[4 * g], v1 = P[4 * g + 1], v2 = P[4 * g + 2], v3 = P[4 * g + 3];
                const int sl = 8 * g;
                if (DIR == 0) { v0 = (sl + 0 <= rel) ? v0 : 0.f; v1 = (sl + 1 <= rel) ? v1 : 0.f; v2 = (sl + 2 <= rel) ? v2 : 0.f; v3 = (sl + 3 <= rel) ? v3 : 0.f; }
                else          { v0 = (sl + 0 >= rel) ? v0 : 0.f; v1 = (sl + 1 >= rel) ? v1 : 0.f; v2 = (sl + 2 >= rel) ? v2 : 0.f; v3 = (sl + 3 >= rel) ? v3 : 0.f; }
                u32x2 o; o.x = pk2(v0, v1); o.y = pk2(v2, v3);
                *(LAS u32x2*)(pp + 16 * g) = o;
            }
        }
        __syncthreads();
        f32x16 o;
#pragma unroll
        for (int i = 0; i < 16; ++i) o[i] = 0.f;
        {   const LAS unsigned char* ap = L + hg::O_ST + (32 * ebo + r) * hg::S128 + 16 * hh;
            const LAS unsigned char* bp = L + hg::O_QH + (32 * tb + r) * hg::S128 + 16 * hh;
#pragma unroll 4
            for (int kq = 0; kq < 8; ++kq) {
                const bf16x8 a = *(const LAS bf16x8*)(ap + 32 * kq);
                const bf16x8 bb = *(const LAS bf16x8*)(bp + 32 * kq);
                o = __builtin_amdgcn_mfma_f32_32x32x16_bf16(a, bb, o, 0, 0, 0);
            }
        }
        {   const LAS unsigned char* ap = L + hg::O_VT + (32 * ebo + r) * hg::S64 + 16 * hh;
            const LAS unsigned char* bp = L + hg::O_P + (32 * tb + r) * hg::S64 + 16 * hh;
#pragma unroll
            for (int kq = 0; kq < 4; ++kq) {
                const bf16x8 a = *(const LAS bf16x8*)(ap + 32 * kq);
                const bf16x8 bb = *(const LAS bf16x8*)(bp + 32 * kq);
                o = __builtin_amdgcn_mfma_f32_32x32x16_bf16(a, bb, o, 0, 0, 0);
            }
        }
        hg::state_update(F, S);
        unsigned* ofp = ofs + ch * 4096 + F.tid;
        if (DIR == 0) {
#pragma unroll
            for (int i = 0; i < 8; ++i) { const unsigned ov = pk2(o[2 * i], o[2 * i + 1]); if (!dry) ofp[i * 512] = ov; else asm volatile("" :: "v"(ov)); }
        } else {
            float ss = 0.f;
#pragma unroll
            for (int i = 0; i < 8; ++i) { const unsigned ov = ofp[i * 512]; o[2 * i] += bflo(ov); o[2 * i + 1] += bfhi(ov); ss += o[2 * i] * o[2 * i] + o[2 * i + 1] * o[2 * i + 1]; }
            ss += __shfl_xor(ss, 32);
            LAS float* rms = (LAS float*)(L + hg::O_RMS) + (32 * tb + r) * 4;
            if (hh == 0) rms[ebo] = ss;
            __syncthreads();
            const f32x4 q4 = *(const LAS f32x4*)rms;
            const float rs = rsqrtf_(((q4.x + q4.y) + (q4.z + q4.w)) * (1.0f / HD) + EPS);
            const float* gwp = F.a->in[9] + (size_t)l * HD + 32 * ebo + 4 * hh;
            bf16_t* op = QV + (size_t)(rowc + 32 * tb) * 2048 + h * 128 + 32 * ebo;
            const unsigned loff = (unsigned)(r * 2048 + 4 * hh);
#pragma unroll
            for (int g = 0; g < 4; ++g) {
                const f32x4 gw = *(const f32x4*)(gwp + 8 * g);
                u32x2 ov; ov.x = pk2(o[4 * g] * rs * gw.x, o[4 * g + 1] * rs * gw.y); ov.y = pk2(o[4 * g + 2] * rs * gw.z, o[4 * g + 3] * rs * gw.w);
                if (!dry) *(u32x2*)(op + loff + 8 * g) = ov; else asm volatile("" :: "v"(ov));
            }
        }
    }
    __syncthreads();
}
__device__ __forceinline__ void hgrn_c_item(const Frame& F, int l, int it, int itn  , bool dry, unsigned (&rf)[8], unsigned (&rq)[8], unsigned (&rv)[8], bool& pre) {
    bf16_t* QV = (bf16_t*)(F.ws + WS_QV);
    int b, h, row0, itl;
    if (it < 512) { itl = it; const int j = it & 31; h = (it >> 5) & 7; b = it >> 8; row0 = b * SEQ + 256 * j; }
    else { itl = -1; const int q = it - 512; h = q & 7; b = q >> 3; row0 = ML + b * CTXL; }

    unsigned* ofs = itl >= 0 ? (unsigned*)(F.ws + WS_ST) + (size_t)(((itl >> 5) * 2 + 0) * 32 + (itl & 31)) * 16384 : (unsigned*)(F.ws + WS_END) + (size_t)(it - 512) * 16384;
    hgrn_c_dir<0>(F, l, itl, h, row0, QV, ofs, dry, rf, rq, rv, pre, -1);
    hgrn_c_dir<1>(F, l, itl, h, row0, QV, ofs, dry, rf, rq, rv, true, itn);
    pre = itn >= 0;
}

__device__ __forceinline__ void conv1d_phase(const Frame& F, int l, int nrows) {
    constexpr int TT = 16, NR = 48;
    const bf16_t* U = (const bf16_t*)(F.ws + WS_S2); bf16_t* QV = (bf16_t*)(F.ws + WS_QV);
    LAS unsigned char* ut = F.lds;
    LAS float* red = (LAS float*)F.lds;
    LAS float* red2 = (LAS float*)(F.lds + NR * 2048);
    LAS float* fin = red2 + 2 * TT * 32;
    const int tid = F.tid, c = 2 * tid;
    const float* wp = F.a->in[11] + (size_t)l * CONVK * D + c;
    const f32x2 cb = *(const f32x2*)(F.a->in[12] + (size_t)l * D + c), lw = *(const f32x2*)(F.a->in[13] + (size_t)l * D + c), lbv = *(const f32x2*)(F.a->in[14] + (size_t)l * D + c);
    const int srow = tid >> 7, scol = (tid & 127) * 8;
    u32x4 pre[NR / 4];
    auto load_tile = [&](int item) {
        const int r0 = item * TT;
        const int slo = r0 < ML ? (r0 / SEQ) * SEQ : ML + ((r0 - ML) / CTXL) * CTXL, shi = slo + (r0 < ML ? SEQ : CTXL);
#pragma unroll
        for (int k = 0; k < NR / 4; ++k) {
            const int rr = r0 - 15 + srow + 4 * k, rc = min(max(rr, slo), shi - 1); const unsigned msk = (unsigned)-(int)(rr == rc);
            const u32x4 v = *(const u32x4*)(U + (size_t)rc * D + scol);
            pre[k] = (u32x4){v.x & msk, v.y & msk, v.z & msk, v.w & msk};
        }
    };
    const int nI = nrows / TT, nfull = nI / F.G, ntail = nI - nfull * F.G, tbase = (F.G >= 128 && ntail <= F.G - 64) ? 64 : 0;
    auto item_of = [&](int k) -> int { if (k < nfull) return F.vcu + k * F.G; const int j = (int)blockIdx.x - tbase; return (k == nfull && j >= 0 && j < ntail) ? nfull * F.G + j : -1; };
    if (item_of(0) >= 0) load_tile(item_of(0));
    for (int k = 0; ; ++k) {
        const int it = item_of(k); if (it < 0) break;
        const int row0 = it * TT;
        __syncthreads();
#pragma unroll
        for (int k = 0; k < NR / 4; ++k) *(LAS u32x4*)(ut + (srow + 4 * k) * 2048 + scol * 2) = pre[k];
        __syncthreads();
        f32x2 y[TT];
#pragma unroll
        for (int t = 0; t < TT; ++t) y[t] = cb;
        const LAS unsigned char* up = ut + tid * 4;
        f32x2 wn[8];
#pragma unroll
        for (int j = 0; j < 8; ++j) wn[j] = *(const f32x2*)(wp + (size_t)j * D);
#pragma unroll 1
        for (int jb = 0; jb < 32; jb += 8) {
            f32x2 w[8];
#pragma unroll
            for (int j = 0; j < 8; ++j) w[j] = wn[j];
            const int jn = jb + 8 < 32 ? jb + 8 : 0;
#pragma unroll
            for (int j = 0; j < 8; ++j) wn[j] = (jn + j < CONVK) ? *(const f32x2*)(wp + (size_t)(jn + j) * D) : (f32x2){0.f, 0.f};
            const LAS unsigned char* ub = up + jb * 2048;
            f32x2 uu[TT + 7];
#pragma unroll
            for (int k = 0; k < TT + 7; ++k) { const unsigned v = *(const LAS unsigned*)(ub + k * 2048); uu[k] = (f32x2){bflo(v), bfhi(v)}; }
#pragma unroll
            for (int j = 0; j < 8; ++j) {
#pragma unroll
                for (int t = 0; t < TT; ++t) y[t] = __builtin_elementwise_fma(w[j], uu[j + t], y[t]);
            }
        }
        { const int nx_ = item_of(k + 1); load_tile(nx_ >= 0 ? nx_ : it); }
        __syncthreads();
#pragma unroll
        for (int t = 0; t < TT; ++t) { red[(2 * t) * 512 + tid] = y[t].x + y[t].y; red[(2 * t + 1) * 512 + tid] = y[t].x * y[t].x + y[t].y * y[t].y; }
        __syncthreads();
        {
#pragma unroll
            for (int rep = 0; rep < 2; ++rep) { const int o = tid + 512 * rep, st = o >> 5, part = o & 31; float sacc = 0.f;
#pragma unroll
                for (int k = 0; k < 16; ++k) sacc += red[st * 512 + part + 32 * k];
                red2[st * 32 + part] = sacc; }
        }
        __syncthreads();
        if (tid < TT) { float s1 = 0.f, s2 = 0.f;
#pragma unroll
            for (int k = 0; k < 32; ++k) { s1 += red2[(2 * tid) * 32 + ((k + tid) & 31)]; s2 += red2[(2 * tid + 1) * 32 + ((k + tid) & 31)]; }
            const float mean = s1 * (1.0f / D), var = fmaxf(s2 * (1.0f / D) - mean * mean, 0.f);
            fin[2 * tid] = mean; fin[2 * tid + 1] = rsqrtf_(var + EPS); }
        __syncthreads();
#pragma unroll
        for (int t = 0; t < TT; ++t) {
            const f32x2 mr = *(const LAS f32x2*)(fin + 2 * t);
            const float a0 = (y[t].x - mr.x) * mr.y * lw.x + lbv.x, a1 = (y[t].y - mr.x) * mr.y * lw.y + lbv.y;
            *(unsigned*)(QV + (size_t)(row0 + t) * 2048 + 1024 + c) = pk2(siluf_(a0), siluf_(a1));
        }
    }
}

__device__ __forceinline__ void conv2d_phase(const Frame& F, int l, bool with_ctx, bool dry) {
    bf16_t* UV = (bf16_t*)(F.ws + WS_UV);
    const float* W9 = F.a->in[19] + (size_t)l * 9 * FFN; const float* Bc = F.a->in[20] + (size_t)l * FFN;
    const int gw = F.vcu * NWAVES + F.wave, NGW = F.G * NWAVES, lane = F.lane;
    constexpr int NLAT = BATCH * (SEQ / 8) * 11, NCTX = BATCH * (CTXL / 8) * 11;
    const int total = NLAT + (with_ctx ? NCTX : 0);
    for (int it = gw; it < total; it += NGW) {
        const bool isctx = it >= NLAT;
        const int q = isctx ? it - NLAT : it, cc = q % 11, seg = q / 11;
        int tok0, c0, wlim; bool up_ok, dn_ok;
        if (!isctx) { const int b = seg >> 10, r = (seg >> 3) & 127; c0 = (seg & 7) * 8; tok0 = b * SEQ + r * GRIDW + c0; wlim = GRIDW; up_ok = r > 0; dn_ok = r < SEQ / GRIDW - 1; }
        else { const int b = seg >> 5; c0 = (seg & 31) * 8; tok0 = ML + b * CTXL + c0; wlim = CTXL; up_ok = false; dn_ok = false; }
        const int ch = cc * 256 + lane * 4;
        const float* wq = W9 + ch;
        f32x4 w[9];
#pragma unroll
        for (int k = 0; k < 9; ++k) w[k] = *(const f32x4*)(wq + (size_t)k * FFN);
        const f32x4 bias4 = *(const f32x4*)(Bc + ch);
        const bf16_t* ubase = UV + (size_t)tok0 * NUP + ch;
        u32x2 u[3][10];
#pragma unroll
        for (int dy = 0; dy < 3; ++dy) {
            const bool rok = dy == 1 ? true : (dy == 0 ? up_ok : dn_ok);
#pragma unroll
            for (int j = 0; j < 10; ++j) {
                const int col = c0 - 1 + j; const bool ok = rok && col >= 0 && col < wlim;
                const unsigned msk = (unsigned)-(int)ok;
                const long off = (long)(((dy - 1) * GRIDW + (j - 1)) & (int)msk) * NUP;
                const u32x2 t = *(const u32x2*)(ubase + off);
                u[dy][j] = (u32x2){t.x & msk, t.y & msk};
            }
        }
        u32x2 vv[8];
#pragma unroll
        for (int t = 0; t < 8; ++t) vv[t] = *(const u32x2*)(ubase + (size_t)t * NUP + FFN);
#pragma unroll
        for (int t = 0; t < 8; ++t) {
            f32x4 a = bias4;
#pragma unroll
            for (int dy = 0; dy < 3; ++dy)
#pragma unroll
                for (int dx = 0; dx < 3; ++dx) {
                    const u32x2 x = u[dy][t + dx]; const f32x4 ww = w[dy * 3 + dx];
                    a.x += ww.x * bflo(x.x); a.y += ww.y * bfhi(x.x); a.z += ww.z * bflo(x.y); a.w += ww.w * bfhi(x.y);
                }
            const f32x2 g0 = gelu_pk((f32x2){a.x, a.y}), g1 = gelu_pk((f32x2){a.z, a.w});
            u32x2 o; o.x = pk2(g0.x * bflo(vv[t].x), g0.y * bfhi(vv[t].x)); o.y = pk2(g1.x * bflo(vv[t].y), g1.y * bfhi(vv[t].y));
            bf16_t* vp = UV + (size_t)(tok0 + t) * NUP + FFN + ch;
            if (!dry) *(u32x2*)vp = o; else asm volatile("" :: "v"(o));
        }
    }
}

__device__ __forceinline__ void final_norm(const Frame& F) {
    const int gw = F.vcu * NWAVES + F.wave, NGW = F.G * NWAVES, lane = F.lane;
    const float* ssq = (const float*)(F.ws + WS_SSQ);
    for (int row = gw; row < ML; row += NGW) {
        const float rs = EpiCommon::rstd_of(ssq, row);
        float* p = F.out + (size_t)row * D;
#pragma unroll
        for (int q = 0; q < 4; ++q) { const int c = 256 * q + 4 * lane; const f32x4 v = *(const f32x4*)(p + c), w = *(const f32x4*)(F.a->in[22] + c); *(f32x4*)(p + c) = v * rs * w; }
    }
}

constexpr int N_PHASES = 25;
#ifdef VGPR_CAP
__attribute__((amdgpu_num_vgpr(VGPR_CAP)))
#endif
__global__ void __launch_bounds__(NTHR, 2) dit_fwd(Args args) {
    extern __shared__ __attribute__((aligned(16))) unsigned char lds[];
    Frame F;
    F.lds = (LAS unsigned char*)lds;
    const int wave0 = __builtin_amdgcn_readfirstlane((int)threadIdx.x >> 6);
    F.tid = threadIdx.x; F.lane = F.tid & 63; F.wave = wave0;
    F.G = gridDim.x; { const int bx = blockIdx.x; F.vcu = (F.G % 8 == 0) ? (bx % 8) * (F.G / 8) + bx / 8 : bx; }
    F.a = &args; F.out = args.out; F.ws = args.ws;
    volatile LAS unsigned* MISC = (volatile LAS unsigned*)(F.lds + LDSCTL_OFF);
    for (int u = F.tid; u < 64; u += NTHR) MISC[u] = 0u;
    __syncthreads();
    const int lo = args.ph_lo, hi = args.ph_hi;
    XcdBarrier bar; bar.bar = (unsigned*)(F.ws + WS_CTL) + CW_BAR; bar.x = 0; bar.st = nullptr;
    if (hi - lo > 1) bar = xcd_barrier_post((unsigned*)(F.ws + WS_CTL) + CW_BAR, MISC + 8, F.tid);
#ifndef ONLY_PHASE
#define ONLY_PHASE -1
#endif
#define PHON(k) (ONLY_PHASE < 0 || ONLY_PHASE == ((k) < 2 ? (k) : ((k) == 24 ? 24 : 2 + ((k) - 2) % 11)))
#define IN(k) (PHON(k) && lo <= (k) && (k) < hi)
#define PHB() do { int ln_ = (int)__builtin_amdgcn_mbcnt_hi(~0u, __builtin_amdgcn_mbcnt_lo(~0u, 0u)); asm volatile("" : "+v"(ln_)); F.lane = ln_; F.wave = wave0; F.tid = wave0 * 64 + ln_; } while (0)
#define REP(t) for (int rep_ = (args.probe_mask >> (t)) & 1; rep_ >= 0; --rep_)
#define DRY (rep_ > 0)
#define SEAM(k) do { if (IN(k) && IN((k) + 1)) { PHB(); xcd_barrier(bar, F.tid); if ((args.probe_mask >> 13) & 1) xcd_barrier(bar, F.tid); } } while (0)
    bf16_t* Wb = (bf16_t*)(F.ws + WS_W);
    bf16_t* XB = (bf16_t*)(F.ws + WS_XB); bf16_t* QV = (bf16_t*)(F.ws + WS_QV);
    float* SSQ = (float*)(F.ws + WS_SSQ); float* CX = (float*)(F.ws + WS_CX);
    const float* MODF = (const float*)(F.ws + WS_MOD);

#define CTX_SUBS(EPI, nN) do { for (int q_ = (int)blockIdx.x; q_ < 2 * (nN) * 8; q_ += F.G) { const int s_ = (q_ & 7) * (2 * (nN)) + (q_ >> 3); \
        const pg8::Unit uu_{ML / 256 + ((s_ >> 3) & 1), s_ >> 4}; pg8::gemm_sub<EPI>(F.lds, F.tid, g, uu_, s_ & 7, E); } } while (0)
#define CTX_SUB_CUS (F.G > 64 ? 64 : 0)
    if (IN(0)) { PHB(); REP(0) { mod_gemv(F); } } SEAM(0);
    if (IN(1)) { PHB(); REP(1) { convert_weights(F, 0, CV_IN); xb_init(F); } } SEAM(1);
#pragma unroll 1
    for (int l = 0; l < DEPTH; ++l) {
        const int pb = 2 + 11 * l;
        const float* modl = MODF + (size_t)l * 3 * NMOD;
        const bool ctx_full = (l == 0);
        const int Mfull = ctx_full ? MT : ML;
        if (IN(pb + 0)) REP(2) { PHB();
            int cx = (int)blockIdx.x; asm volatile("" : "+s"(cx));
            pg8::Gemm g{XB, Wb + WO_IN / 2, MT, 4096, D, D}; pg8::StaticOrder S; S.init(ML, 4096, F.G, cx);
            EpiG1 E{SSQ, (const float*)(F.ws + WS_BIASIN) + (size_t)l * 3 * PIN, QV, (unsigned short*)(F.ws + WS_S2), (unsigned short*)(F.ws + WS_S3)};
            pg8::gemm_phase<EpiG1>(F.lds, F.tid, g, S, E);
            for (int s = F.vcu; s < 2 * 16 * 8; s += F.G) {
                const pg8::Unit uu{ML / 256 + ((s >> 3) & 1), s >> 4}; pg8::gemm_sub<EpiG1>(F.lds, F.tid, g, uu, s & 7, E); }
        } SEAM(pb + 0);
#pragma unroll 1
        for (int sub = 0; sub < 3; ++sub) {
            const int ph = pb + 1 + sub;
            if (IN(ph)) { PHB(); REP(3 + sub) {
                const bool ctx_here = ctx_full && F.G > 32;
                if (sub == 0) hgrn_phase_a(F, l, ctx_here ? F.G - 16 : F.G);
                if (sub == 1) { hgrn_scan(F, DRY);
                    if (rep_ == 0) convert_weights(F, l, l == 0 ? CV_IN2 : CV_DOWN, F.G > 128 ? 128 : 0); }
                const int first = sub == 0 ? 512 + (F.G - 1 - (int)blockIdx.x) : (int)blockIdx.x, last = sub == 0 ? (ctx_here ? 528 : 0) : (sub == 1 ? (ctx_full && !ctx_here ? 528 : 0) : 512);
                unsigned crf[8] = {}, crq[8] = {}, crv[8] = {}; bool cpre = false;
                for (int it = (sub == 1 ? 512 + (F.G - 1 - (int)blockIdx.x) : first); it < last; it += F.G) hgrn_c_item(F, l, it, it + F.G < last ? it + F.G : -1, DRY, crf, crq, crv, cpre);
            } }
            SEAM(ph);
        }
        if (IN(pb + 4)) REP(6) { PHB(); const bool dry = DRY;
            pg8::Gemm g{XB, Wb + WO_IN / 2 + (size_t)4096 * D, Mfull, 5120, D, D}; pg8::StaticOrder S; S.init(Mfull, 5120, F.G, (int)blockIdx.x);
            EpiG2 E{SSQ, (const float*)(F.ws + WS_BIASIN) + (size_t)l * 3 * PIN, QV, (bf16_t*)(F.ws + WS_S2), (bf16_t*)(F.ws + WS_S3), (bf16_t*)(F.ws + WS_ST), dry};
            pg8::gemm_phase<EpiG2>(F.lds, F.tid, g, S, E);
            if (l == 0 && rep_ == 0) convert_weights(F, 0, CV_HG | CV_CV | CV_OUT | CV_DOWN | CV_UP, (MT / 256 * 20) % 256);
        } SEAM(pb + 4);
        unsigned* SPL = (unsigned*)(F.ws + WS_CTL) + CW_SPLIT + l * 2048;
        if (IN(pb + 5)) { PHB(); REP(7) conv1d_phase(F, l, Mfull); PHB(); split_arrive(bar, SPL, F.tid); }
        if (IN(pb + 6)) REP(8) { PHB();
            { pg8::Gemm g{QV, Wb + WO_HG / 2, Mfull, D, D, 2048}; pg8::StaticOrder S; S.init(ML, D, F.G, (int)blockIdx.x);
              EpiY<1> E{(const bf16_t*)(F.ws + WS_S3), XB, nullptr}; pg8::gemm_phase<EpiY<1>>(F.lds, F.tid, g, S, E);
              if (l == 0) CTX_SUBS(EpiY<1>, 4); }
            PHB(); split_wait(bar, SPL, F.tid);
            { pg8::Gemm g{QV + 1024, Wb + WO_CV / 2, Mfull, D, D, 2048}; pg8::StaticOrder S; S.init(ML, D, F.G, (int)blockIdx.x);
              EpiY<2> E{(const bf16_t*)(F.ws + WS_ST), (bf16_t*)(F.ws + WS_S2), XB}; pg8::gemm_phase<EpiY<2>>(F.lds, F.tid, g, S, E);
              if (l == 0) CTX_SUBS(EpiY<2>, 4); }
            if (l == 0 && rep_ == 0) convert_weights(F, 1, CV_IN | CV_IN2, CTX_SUB_CUS);
        } SEAM(pb + 6);
        if (IN(pb + 7)) REP(9) { PHB(); const bool dry = DRY;
            pg8::Gemm g{(const bf16_t*)(F.ws + WS_S2), Wb + WO_OUT / 2, Mfull, D, D, D}; pg8::StaticOrder S; S.init(ML, D, F.G, (int)blockIdx.x);
            EpiRes E{l == 0 ? F.a->in[0] : F.out, l == 0 ? F.a->in[2] : CX, F.out, CX, modl + 2 * D, F.a->in[17] + (size_t)l * D, modl + 4 * D, XB, SSQ, dry};
            pg8::gemm_phase<EpiRes>(F.lds, F.tid, g, S, E);
            if (l == 0) CTX_SUBS(EpiRes, 4);
            if (l == 0 && rep_ == 0) convert_weights(F, 1, CV_HG | CV_CV, CTX_SUB_CUS);
        } SEAM(pb + 7);
        if (IN(pb + 8)) REP(10) { PHB();
            pg8::Gemm g{XB, Wb + WO_UP / 2, Mfull, NUP, D, D}; pg8::StaticOrder S; S.init(Mfull, NUP, F.G, (int)blockIdx.x);
            EpiUp E{SSQ, (const float*)(F.ws + WS_BIASUP) + (size_t)l * 3 * NUP, (bf16_t*)(F.ws + WS_UV)};
            pg8::gemm_phase<EpiUp>(F.lds, F.tid, g, S, E);
            if (l == 0 && rep_ == 0) convert_weights(F, 1, CV_OUT, (MT / 256 * 22) % 256);
        } SEAM(pb + 8);
        if (IN(pb + 9)) { PHB(); REP(11) conv2d_phase(F, l, ctx_full, DRY); } SEAM(pb + 9);
        if (IN(pb + 10)) REP(12) { PHB(); const bool dry = DRY;
            pg8::Gemm g{(const bf16_t*)(F.ws + WS_UV) + FFN, Wb + WO_DOWN / 2, Mfull, D, FFN, NUP}; pg8::StaticOrder S; S.init(ML, D, F.G, (int)blockIdx.x);
            if (l + 1 < DEPTH) {
                EpiRes E{F.out, CX, F.out, CX, modl + 5 * D, F.a->in[6] + (size_t)(l + 1) * D, MODF + (size_t)(l + 1) * 3 * NMOD + 1 * D, XB, SSQ, dry};
                pg8::gemm_phase<EpiRes>(F.lds, F.tid, g, S, E);
                if (l == 0) CTX_SUBS(EpiRes, 4);
                if (rep_ == 0) convert_weights(F, 1, CV_UP, CTX_SUB_CUS);
            } else if (F.G == 256) {
                EpiFinal E{F.out, modl + 5 * D, F.a->in[22], SSQ, (unsigned*)(F.ws + WS_CTL) + CW_FIN};
                pg8::gemm_phase<EpiFinal>(F.lds, F.tid, g, S, E);
            } else {
                EpiRes E{F.out, CX, F.out, CX, modl + 5 * D, nullptr, MODF + 1 * D, XB, SSQ, dry};
                pg8::gemm_phase<EpiRes>(F.lds, F.tid, g, S, E);
            }
        } if (l + 1 < DEPTH || F.G != 256) SEAM(pb + 10);
    }
    if (IN(24) && F.G != 256) { PHB(); final_norm(F); }
#undef IN
#undef SEAM
}

extern "C" void kernel_launch(void* const* d_in, const int* in_sizes, int n_in, void* d_out, int out_size, void* d_ws, size_t ws_size, hipStream_t stream) {
    static int grid = 0;
    if (grid == 0) {
        if (n_in != 23 || out_size != ML * D || ws_size < WS_END + 16 * 65536) { fprintf(stderr, "kernel_launch: unexpected shapes (n_in %d out %d ws %zu)\n", n_in, out_size, ws_size); grid = -1; return; }
        int dev = 0, cus = 0;
        if (hipGetDevice(&dev) != hipSuccess || hipDeviceGetAttribute(&cus, hipDeviceAttributeMultiprocessorCount, dev) != hipSuccess) { grid = -1; return; }
        if (hipFuncSetAttribute((const void*)dit_fwd, hipFuncAttributeMaxDynamicSharedMemorySize, LDS_BYTES) != hipSuccess) { fprintf(stderr, "kernel_launch: hipFuncSetAttribute failed\n"); grid = -1; return; }
        (void)hipGetLastError();
        grid = cus;
    }
    if (grid < 0) return;
    (void)hipMemsetAsync((char*)d_ws + WS_CTL, 0, CTL_ZERO_BYTES, stream);
    Args a{};
    for (int i = 0; i < 23; ++i) a.in[i] = (const float*)d_in[i];
    a.out = (float*)d_out; a.ws = (unsigned char*)d_ws;
#ifdef PROBE_MASK
    a.probe_mask = PROBE_MASK;
#endif
#if MK_N_LAUNCHES == 1
    a.ph_lo = 0; a.ph_hi = N_PHASES;
    hipLaunchKernelGGL(dit_fwd, dim3(grid), dim3(NTHR), LDS_BYTES, stream, a);
#else
    for (int p = 0; p < N_PHASES; ++p) { a.ph_lo = p; a.ph_hi = p + 1; hipLaunchKernelGGL(dit_fwd, dim3(grid), dim3(NTHR), LDS_BYTES, stream, a); }
#endif
}
```

```cpp
#include <hip/hip_runtime.h>
#include <cstdio>
#include <cstdint>

#ifndef MK_N_LAUNCHES
#define MK_N_LAUNCHES 1
#endif

#define LAS __attribute__((address_space(3)))
#define GAS __attribute__((address_space(1)))
typedef unsigned short bf16_t;
typedef short bf16x8 __attribute__((ext_vector_type(8)));
typedef float f32x4 __attribute__((ext_vector_type(4)));
typedef float f32x2 __attribute__((ext_vector_type(2)));
typedef float f32x16 __attribute__((ext_vector_type(16)));
typedef unsigned u32x4 __attribute__((ext_vector_type(4)));
typedef unsigned u32x2 __attribute__((ext_vector_type(2)));
typedef GAS unsigned gu32;

constexpr int D = 1024, BATCH = 2, SEQ = 8192, CTXL = 256, DEPTH = 2;
constexpr int ML = BATCH * SEQ, MC = BATCH * CTXL, MT = ML + MC;
constexpr int PIN = 9216, FFN = 2816, NUP = 2 * FFN, NH = 8, HD = 128, NMOD = 6 * D;
constexpr int GRIDW = 64, CONVK = 31;
constexpr float EPS = 1e-6f, GMIN = 1e-6f;
constexpr int NWAVES = 8, NTHR = 512;

constexpr size_t MiB = 1u << 20;
constexpr size_t RB = (size_t)MT * D * 2;
constexpr size_t WS_CTL = 0, CTL_ZERO_BYTES = 128 * 1024;
constexpr size_t WS_MODP = 1 * MiB;
constexpr size_t WS_MOD = WS_MODP + (size_t)2 * 16 * 3 * NMOD * 4;
constexpr size_t WS_BIASIN = WS_MOD + (size_t)2 * 3 * NMOD * 4;
constexpr size_t WS_BIASUP = WS_BIASIN + (size_t)2 * 3 * PIN * 4;
constexpr size_t WS_BIASP = WS_BIASUP + (size_t)2 * 3 * NUP * 4;
constexpr size_t WS_BIASP2 = WS_BIASP + (size_t)16 * 3 * PIN * 4;
constexpr size_t WS_SSQ = WS_BIASP2 + (size_t)16 * 3 * NUP * 4;
constexpr size_t WS_DV = WS_SSQ + (size_t)MT * 16 * 4;
constexpr size_t WS_CX = WS_DV + (size_t)1056 * 128 * 4;
constexpr size_t WS_SMALL_END = WS_CX + (size_t)MC * D * 4;
static_assert(WS_SMALL_END <= 11 * MiB, "small region");
constexpr size_t WS_W = 11 * MiB;
constexpr size_t WO_IN = 0, WO_HG = (size_t)PIN * D * 2, WO_CV = WO_HG + (size_t)D * D * 2, WO_OUT = WO_CV + (size_t)D * D * 2,
                 WO_UP = WO_OUT + (size_t)D * D * 2, WO_DOWN = WO_UP + (size_t)NUP * D * 2, WO_END = WO_DOWN + (size_t)D * FFN * 2;
static_assert(WO_END <= 41 * MiB, "weights");
constexpr size_t WS_XR = 52 * MiB;
constexpr size_t WS_BIG = 85 * MiB;
constexpr size_t WS_QV = WS_BIG;
constexpr size_t WS_S2 = WS_BIG + 2 * RB;
constexpr size_t WS_S3 = WS_BIG + 3 * RB;
constexpr size_t WS_ST = WS_BIG + 4 * RB;
constexpr size_t WS_UV = WS_BIG;
constexpr size_t WS_END = WS_BIG + 6 * RB;
static_assert(WS_END + 16 * 65536 <= 288 * MiB && (size_t)MT * NUP * 2 <= 6 * RB, "ws map");

constexpr int CW_BAR = 4096;
constexpr int CW_CNT_MOD = 8192;
constexpr int CW_CNT_IN = 8192 + 64;
constexpr int CW_CNT_UP = CW_CNT_IN + 2 * 288;
constexpr int CW_SPLIT = 20480;
constexpr int CW_FIN = 16384;

constexpr int RING_BYTES = 131072;
constexpr int LDSCTL_OFF = RING_BYTES + 8192;
constexpr int LDS_BYTES = 147456;

typedef __bf16 bf16x2_t __attribute__((ext_vector_type(2)));
__device__ __forceinline__ unsigned pk2(float lo, float hi) { const f32x2 v = {lo, hi}; const bf16x2_t b = __builtin_convertvector(v, bf16x2_t); return __builtin_bit_cast(unsigned, b); }
__device__ __forceinline__ unsigned f2bf(float f) { return pk2(f, f) & 0xffffu; }
__device__ __forceinline__ float bf2f(unsigned b) { return __builtin_bit_cast(float, (b & 0xffffu) << 16); }
__device__ __forceinline__ float bflo(unsigned w) { return __builtin_bit_cast(float, w << 16); }
__device__ __forceinline__ float bfhi(unsigned w) { return __builtin_bit_cast(float, w & 0xffff0000u); }
__device__ __forceinline__ unsigned pkh2(float lo, float hi) { _Float16 a = (_Float16)lo, b = (_Float16)hi; return (unsigned)__builtin_bit_cast(unsigned short, a) | ((unsigned)__builtin_bit_cast(unsigned short, b) << 16); }
typedef _Float16 f16x2_t __attribute__((ext_vector_type(2)));
__device__ __forceinline__ f32x2 unpkh2(unsigned w) { return __builtin_convertvector(__builtin_bit_cast(f16x2_t, w), f32x2); }
__device__ __forceinline__ float sigmoidf_(float x) { return __builtin_amdgcn_rcpf(1.0f + __builtin_amdgcn_exp2f(x * -1.4426950408889634f)); }
__device__ __forceinline__ float siluf_(float x) { return x * sigmoidf_(x); }
__device__ __forceinline__ float rsqrtf_(float x) { return __builtin_amdgcn_rsqf(x); }
__device__ __forceinline__ float wave_sum(float v) {
#pragma unroll
    for (int o = 1; o < 64; o <<= 1) v += __shfl_xor(v, o);
    return v;
}
__device__ __forceinline__ f32x2 gelu_pk(f32x2 v) {
    const f32x2 av = __builtin_elementwise_abs(v), d = av * 0.2316418882f + 1.0f;
    f32x2 t; t.x = __builtin_amdgcn_rcpf(d.x); t.y = __builtin_amdgcn_rcpf(d.y);
    f32x2 q = t * 0.5307027145f + (-0.7265760135f); q = q * t + 0.7107068705f; q = q * t + (-0.142248368f); q = q * t + 0.127414796f; q = q * t;
    const f32x2 s = (v * v) * (-0.72134752044f);
    f32x2 e; e.x = __builtin_amdgcn_exp2f(s.x); e.y = __builtin_amdgcn_exp2f(s.y);
    const f32x2 m = v * (q * e), r = v - m;
    f32x2 o; o.x = v.x < 0.f ? m.x : r.x; o.y = v.y < 0.f ? m.y : r.y; return o;
}
#define LDS_WAIT() asm volatile("s_waitcnt lgkmcnt(0)" ::: "memory")
#define VM_WAIT() asm volatile("s_waitcnt vmcnt(0)" ::: "memory")
#define RLX_AGENT __ATOMIC_RELAXED, __HIP_MEMORY_SCOPE_AGENT

namespace pg8 {
constexpr int BM = 256, BK = 64, HALF = 128, HTB = HALF * BK * 2, STAGE_BYTES = 8 * HTB, NXCD = 8, WGM = 6;
__host__ __device__ __forceinline__ int lds_byte(int r, int c) { const int st = (r >> 4) * 2 + (c >> 5), rr = r & 15, cc = c & 31, ob = rr * 64 + cc * 2; return st * 1024 + (ob ^ (((ob >> 9) & 1) << 5)); }
__host__ __device__ __forceinline__ void stage_rc(int b, int& R, int& C) { const int st = b / 1024, sb = b % 1024, swz = sb ^ (((sb >> 9) & 1) << 5); R = (st >> 1) * 16 + swz / 64; C = (st & 1) * 32 + (swz % 64) / 2; }
__host__ __device__ __forceinline__ int perm32(int rho) { const int n = rho >> 4, i = rho & 15; return 8 * (i >> 2) + 4 * n + (i & 3); }
struct Unit { int pm, pn, ui; };
struct Gemm { const bf16_t* A; const bf16_t* Bt; int M, N, K, lda; };
struct StaticOrder {
    int nM, nN, nwg, G, c;
    __device__ void init(int M, int N, int G_, int c_) { nM = M / BM; nN = N / BM; nwg = nM * nN; G = G_; c = c_; }
    __device__ bool next(int i, Unit& u) const {
        const long L = (long)i * G + c; if (L >= nwg) return false;
        int wgid = (int)L; { const int q = nwg / NXCD, r = nwg % NXCD, xcd = wgid % NXCD, off = wgid / NXCD; wgid = (xcd < r ? xcd * (q + 1) : r * (q + 1) + (xcd - r) * q) + off; }
        const int nig = WGM * nN, gid = wgid / nig, fm = gid * WGM, gsz = (nM - fm) < WGM ? (nM - fm) : WGM;
        u.pm = fm + ((wgid % nig) % gsz); u.pn = (wgid % nig) / gsz; return true;
    }
};
template <class Epi>
__device__ __forceinline__ void gemm_phase(LAS unsigned char* lds, const int tid, const Gemm g, const StaticOrder& S, const Epi& E) {
    const int wid = __builtin_amdgcn_readfirstlane(tid >> 6), lane = tid & 63, wr = wid >> 2, wc = wid & 3, fr = lane & 15, fq = lane >> 4;
    const int K = g.K, nt = K / BK, lda = g.lda;
    unsigned voffA[2], voffB[2];
#pragma unroll
    for (int i = 0; i < 2; ++i) { int R, C; stage_rc(tid * 16 + i * 8192, R, C); const int Rb = (R & ~31) + perm32(R & 31);
        voffA[i] = (unsigned)(R * lda + C) * 2u; voffB[i] = (unsigned)(Rb * K + C) * 2u; }
    const size_t kstep = (size_t)(BK * 2);
    const size_t hstepA = (size_t)HALF * lda * 2, hstepB = (size_t)HALF * K * 2;
    const size_t tstepA = 2 * hstepA, tstepB = 2 * hstepB;
    const unsigned ldsw = (unsigned)wid * 1024u;
    const int aoff = lds_byte(wr * 64 + fr, fq * 8), boff = lds_byte(wc * 32 + fr, fq * 8);
#define PG8_SA(b, h) (((b) * 2 + (h)) * HTB)
#define PG8_SB(b, h) ((4 + (b) * 2 + (h)) * HTB)
#define PG8_STAGE(bufoff, gbase, voff) do { _Pragma("unroll") for (int _i = 0; _i < 2; ++_i) \
        __builtin_amdgcn_global_load_lds((const unsigned*)((const char*)(gbase) + (voff)[_i]), (LAS unsigned*)(lds + (bufoff) + ldsw + _i * 8192), 16, 0, 0); } while (0)
#define PG8_LDA(dst, b, h) do { _Pragma("unroll") for (int m = 0; m < 4; ++m) _Pragma("unroll") for (int k = 0; k < 2; ++k) dst[m][k] = *(const LAS bf16x8*)(lds + PG8_SA(b, h) + aoff + m * 2048 + k * 1024); } while (0)
#define PG8_LDB(dst, b, h) do { _Pragma("unroll") for (int n = 0; n < 2; ++n) _Pragma("unroll") for (int k = 0; k < 2; ++k) dst[n][k] = *(const LAS bf16x8*)(lds + PG8_SB(b, h) + boff + n * 2048 + k * 1024); } while (0)
#define PG8_MMA(ai, bj, At, Bt) do { __builtin_amdgcn_s_setprio(1); _Pragma("unroll") for (int m = 0; m < 4; ++m) _Pragma("unroll") for (int n = 0; n < 2; ++n) _Pragma("unroll") for (int k = 0; k < 2; ++k) \
        acc[ai][bj][m][n] = __builtin_amdgcn_mfma_f32_16x16x32_bf16(Bt[n][k], At[m][k], acc[ai][bj][m][n], 0, 0, 0); __builtin_amdgcn_s_setprio(0); } while (0)
#define PG8_WAIT_V(n) asm volatile("s_waitcnt vmcnt(" #n ")" ::: "memory")
#define PG8_WAIT_L(n) asm volatile("s_waitcnt lgkmcnt(" #n ")" ::: "memory")
#define PG8_BAR __builtin_amdgcn_s_barrier()
#define PG8_SCHED __builtin_amdgcn_sched_barrier(0)
    Unit cur, nxt; int ui = 0;
    if (!S.next(0, cur)) return;
    f32x4 acc[2][2][4][2];
#pragma unroll
    for (int a = 0; a < 2; ++a)
#pragma unroll
        for (int b = 0; b < 2; ++b)
#pragma unroll
            for (int m = 0; m < 4; ++m)
#pragma unroll
                for (int n = 0; n < 2; ++n) acc[a][b][m][n] = (f32x4){0.f, 0.f, 0.f, 0.f};
    bf16x8 At[4][2], B0[2][2], B1[2][2];
    const char* cA = (const char*)g.A + (size_t)cur.pm * tstepA; const char* cB = (const char*)g.Bt + (size_t)cur.pn * tstepB;
    PG8_STAGE(PG8_SB(0, 0), cB, voffB); PG8_STAGE(PG8_SB(0, 1), cB + hstepB, voffB); PG8_STAGE(PG8_SA(0, 0), cA, voffA); PG8_STAGE(PG8_SA(0, 1), cA + hstepA, voffA);
    if (wr == 1) PG8_BAR;
    PG8_WAIT_V(2); PG8_BAR;
    PG8_STAGE(PG8_SB(1, 0), cB + kstep, voffB); PG8_STAGE(PG8_SA(1, 0), cA + kstep, voffA); PG8_STAGE(PG8_SB(1, 1), cB + hstepB + kstep, voffB);
    PG8_WAIT_V(6); PG8_BAR;
    for (;;) {
        const bool has_next = S.next(ui + 1, nxt);
        const char* nA = has_next ? (const char*)g.A + (size_t)nxt.pm * tstepA : cA; const char* nB = has_next ? (const char*)g.Bt + (size_t)nxt.pn * tstepB : cB;
        for (int t = 0; t < nt; t += 2) {
            const bool last = (t == nt - 2);
            const char* a1 = cA + (size_t)(t + 1) * kstep;
            const char* a2 = last ? nA : cA + (size_t)(t + 2) * kstep; const char* b2 = last ? nB : cB + (size_t)(t + 2) * kstep;
            const char* a3 = a2 + kstep; const char* b3 = b2 + kstep;
            PG8_LDB(B0, 0, 0); PG8_LDB(B1, 0, 1); PG8_SCHED; PG8_LDA(At, 0, 0); PG8_STAGE(PG8_SA(1, 1), a1 + hstepA, voffA);
            PG8_WAIT_V(8); PG8_WAIT_L(0); PG8_BAR; PG8_MMA(0, 0, At, B0); PG8_MMA(0, 1, At, B1); PG8_BAR; PG8_SCHED;
            PG8_LDA(At, 0, 1); PG8_STAGE(PG8_SB(0, 0), b2, voffB); PG8_STAGE(PG8_SB(0, 1), b2 + hstepB, voffB); PG8_STAGE(PG8_SA(0, 0), a2, voffA);
            PG8_WAIT_V(8); PG8_WAIT_L(0); PG8_BAR; PG8_MMA(1, 0, At, B0); PG8_MMA(1, 1, At, B1); PG8_BAR; PG8_SCHED;
            PG8_LDB(B0, 1, 0); PG8_LDB(B1, 1, 1); PG8_SCHED; PG8_LDA(At, 1, 0); PG8_STAGE(PG8_SA(0, 1), a2 + hstepA, voffA);
            PG8_WAIT_V(8); PG8_WAIT_L(0); PG8_BAR; PG8_MMA(0, 0, At, B0); PG8_MMA(0, 1, At, B1); PG8_BAR; PG8_SCHED;
            PG8_LDA(At, 1, 1); PG8_STAGE(PG8_SB(1, 0), b3, voffB); PG8_STAGE(PG8_SB(1, 1), b3 + hstepB, voffB); PG8_STAGE(PG8_SA(1, 0), a3, voffA);
            PG8_WAIT_V(8); PG8_WAIT_L(0); PG8_BAR; PG8_MMA(1, 0, At, B0); PG8_MMA(1, 1, At, B1); PG8_BAR; PG8_SCHED;
        }
        if (wr == 0) PG8_BAR;
        { Unit cu = cur; cu.ui = ui; E(acc, cu, 0, wr, wc, fr, fq); }
        if (!has_next) break;
#pragma unroll
        for (int a = 0; a < 2; ++a)
#pragma unroll
            for (int b = 0; b < 2; ++b)
#pragma unroll
                for (int m = 0; m < 4; ++m)
#pragma unroll
                    for (int n = 0; n < 2; ++n) acc[a][b][m][n] = (f32x4){0.f, 0.f, 0.f, 0.f};
        cur = nxt; cA = nA; cB = nB; ++ui;
        if (wr == 1) PG8_BAR;
    }
    PG8_WAIT_V(0);
    PG8_BAR;
#undef PG8_SA
#undef PG8_SB
#undef PG8_STAGE
#undef PG8_LDA
#undef PG8_LDB
#undef PG8_MMA
#undef PG8_WAIT_V
#undef PG8_WAIT_L
#undef PG8_BAR
#undef PG8_SCHED
}
template <class Epi>
__device__ __forceinline__ void gemm_sub(LAS unsigned char* lds, const int tid, const Gemm g, const Unit u, const int sub, const Epi& E) {
    const int wid = __builtin_amdgcn_readfirstlane(tid >> 6), lane = tid & 63, wr = wid >> 2, wc = wid & 3, fr = lane & 15, fq = lane >> 4;
    const int ro = (sub >> 2) * 128 + (sub & 3) * 16, K = g.K, nt = K / BK, lda = g.lda;
    constexpr int SBUF = 2 * HTB + 4096;
    unsigned voffB[2], voffA;
#pragma unroll
    for (int i = 0; i < 2; ++i) { int R, C; stage_rc(tid * 16 + i * 8192, R, C); const int Rb = (R & ~31) + perm32(R & 31); voffB[i] = (unsigned)(Rb * K + C) * 2u; }
    { int R, C; stage_rc((tid & 255) * 16, R, C); voffA = (unsigned)(((R & 15) + 64 * (R >> 4)) * lda + C) * 2u; }
    const char* cA = (const char*)g.A + (size_t)(u.pm * BM + ro) * lda * 2;
    const char* cB = (const char*)g.Bt + (size_t)u.pn * BM * K * 2;
    const size_t hstepB = (size_t)HALF * K * 2;
    const unsigned ldsw = (unsigned)wid * 1024u, ldswA = (unsigned)(wid & 3) * 1024u;
    const int aoff = lds_byte(wr * 16 + fr, fq * 8), boff = lds_byte(wc * 32 + fr, fq * 8);
#define PGS_STAGE(t_, b_) do { const char* gb_ = cB + (size_t)(t_) * (BK * 2); const char* ga_ = cA + (size_t)(t_) * (BK * 2); LAS unsigned char* lb_ = lds + (b_) * SBUF; \
        _Pragma("unroll") for (int h_ = 0; h_ < 2; ++h_) _Pragma("unroll") for (int i_ = 0; i_ < 2; ++i_) \
            __builtin_amdgcn_global_load_lds((const unsigned*)(gb_ + h_ * hstepB + voffB[i_]), (LAS unsigned*)(lb_ + h_ * HTB + ldsw + i_ * 8192), 16, 0, 0); \
        __builtin_amdgcn_global_load_lds((const unsigned*)(ga_ + voffA), (LAS unsigned*)(lb_ + 2 * HTB + ldswA), 16, 0, 0); } while (0)
    f32x4 acc[1][2][1][2];
#pragma unroll
    for (int bj = 0; bj < 2; ++bj)
#pragma unroll
        for (int n = 0; n < 2; ++n) acc[0][bj][0][n] = (f32x4){0.f, 0.f, 0.f, 0.f};
    __builtin_amdgcn_s_barrier();
    PGS_STAGE(0, 0); PGS_STAGE(1, 1);
    int bc = 0;
#pragma unroll 1
    for (int t = 0; t < nt; ++t) {
        if (t + 1 < nt) asm volatile("s_waitcnt vmcnt(5)" ::: "memory"); else asm volatile("s_waitcnt vmcnt(0)" ::: "memory");
        __builtin_amdgcn_s_barrier();
        if (t + 2 < nt) { const int bn = bc + 2 >= 3 ? bc - 1 : bc + 2; PGS_STAGE(t + 2, bn); }
        const LAS unsigned char* lb = lds + bc * SBUF;
        bf16x8 At[2], Bf[2][2][2];
#pragma unroll
        for (int k = 0; k < 2; ++k) At[k] = *(const LAS bf16x8*)(lb + 2 * HTB + aoff + k * 1024);
#pragma unroll
        for (int bj = 0; bj < 2; ++bj)
#pragma unroll
            for (int n = 0; n < 2; ++n)
#pragma unroll
                for (int k = 0; k < 2; ++k) Bf[bj][n][k] = *(const LAS bf16x8*)(lb + bj * HTB + boff + n * 2048 + k * 1024);
#pragma unroll
        for (int k = 0; k < 2; ++k)
#pragma unroll
            for (int bj = 0; bj < 2; ++bj)
#pragma unroll
                for (int n = 0; n < 2; ++n) acc[0][bj][0][n] = __builtin_amdgcn_mfma_f32_16x16x32_bf16(Bf[bj][n][k], At[k], acc[0][bj][0][n], 0, 0, 0);
        bc = bc + 1 == 3 ? 0 : bc + 1;
    }
#undef PGS_STAGE
    E(acc, u, ro, wr, wc, fr, fq);
}
}

#define XB_TMO      128
#define XB_XCNT(j)  (256  + 64 * (j))
#define XB_XSUB(j)  (1280 + 64 * (j))
#define XB_XGEN(j)  (2304 + 64 * (j))
#define XB_TOP      3328
#define XB_TOPGEN   3392
#define XCD_BAR_WORDS 3456
#define XB_SPIN_CAP (1u << 18)
__device__ __forceinline__ unsigned xb_ld(unsigned* p)              { return __hip_atomic_load(p, __ATOMIC_RELAXED, __HIP_MEMORY_SCOPE_AGENT); }
__device__ __forceinline__ unsigned xb_add(unsigned* p, unsigned v) { return __hip_atomic_fetch_add(p, v, __ATOMIC_RELAXED, __HIP_MEMORY_SCOPE_AGENT); }
__device__ __forceinline__ unsigned xb_xcc_id() { return (unsigned)__builtin_amdgcn_s_getreg((3 << 11) | 20) & 0xFu; }
#define XB_SPIN(cond, bar) do { unsigned _sp = 0; while (cond) { __builtin_amdgcn_s_sleep(1); \
    if ((++_sp & 255u) == 0u) { if (xb_ld(&(bar)[XB_TMO])) break; if (_sp > XB_SPIN_CAP) { atomicAdd(&(bar)[XB_TMO], 1u); break; } } } } while (0)
struct XcdBarrier { unsigned* bar; unsigned x; volatile LAS unsigned* st; };
__device__ __forceinline__ XcdBarrier xcd_barrier_post(unsigned* bar, volatile LAS unsigned* st, int tid) {
    XcdBarrier b; b.bar = bar; b.x = xb_xcc_id(); b.st = st;
    if (tid == 0) (void)xb_add(&bar[XB_XCNT(b.x)], 1u);
    return b;
}
__device__ __forceinline__ void xcd_barrier_complete(unsigned* bar, unsigned x, unsigned& nloc, unsigned& nx) {
    const unsigned G = gridDim.x * gridDim.y * gridDim.z;
    unsigned sum, cnt, mine, sp = 0u;
    for (;;) {
        sum = 0u; cnt = 0u; mine = 0u;
#pragma unroll
        for (unsigned j = 0; j < 16; ++j) { const unsigned c = xb_ld(&bar[XB_XCNT(j)]); sum += c; cnt += (c > 0u) ? 1u : 0u; mine = (j == x) ? c : mine; }
        if (sum == G) break;
        __builtin_amdgcn_s_sleep(1);
        if ((++sp & 255u) == 0u) { if (xb_ld(&bar[XB_TMO])) break; if (sp > XB_SPIN_CAP) { atomicAdd(&bar[XB_TMO], 1u); break; } }
    }
    nloc = mine > 0u ? mine : 1u; nx = cnt > 0u ? cnt : 1u;
}
__device__ __forceinline__ void xcd_barrier(const XcdBarrier& b, int tid) {
    asm volatile("s_waitcnt vmcnt(0)" ::: "memory");
    __syncthreads();
    if (tid == 0) {
        unsigned* bar = b.bar;
        __builtin_amdgcn_s_waitcnt(0);
        unsigned nloc = b.st[0], nx = b.st[1];
        if (nloc == 0u) { xcd_barrier_complete(bar, b.x, nloc, nx); b.st[0] = nloc; b.st[1] = nx; }
        const unsigned old = xb_add(&bar[XB_XSUB(b.x)], 1u);
        const unsigned gen = old / nloc;
        if (old + 1u == (gen + 1u) * nloc) {
            __builtin_amdgcn_fence(__ATOMIC_RELEASE, "agent");
            asm volatile("s_waitcnt vmcnt(0)" ::: "memory");
            const unsigned og = xb_add(&bar[XB_TOP], 1u);
            const unsigned tg = og / nx;
            if (og + 1u == (tg + 1u) * nx) xb_add(&bar[XB_TOPGEN], 1u);
            else XB_SPIN(xb_ld(&bar[XB_TOPGEN]) == tg, bar);
            __builtin_amdgcn_fence(__ATOMIC_ACQUIRE, "agent");
            xb_add(&bar[XB_XGEN(b.x)], 1u);
            asm volatile("s_waitcnt vmcnt(0)" ::: "memory");
        } else {
            XB_SPIN(xb_ld(&bar[XB_XGEN(b.x)]) == gen, bar);
            __builtin_amdgcn_fence(__ATOMIC_ACQUIRE, "agent");
            asm volatile("s_waitcnt vmcnt(0)" ::: "memory");
        }
    }
    __syncthreads();
}

#define XS_XCNT(j) (64 * (j))
#define XS_TOP 1024
__device__ __forceinline__ void split_arrive(const XcdBarrier& b, unsigned* w, int tid) {
    if (b.st == nullptr) return;
    asm volatile("s_waitcnt vmcnt(0)" ::: "memory");
    __syncthreads();
    if (tid == 0) {
        unsigned nloc = b.st[0], nx = b.st[1];
        if (nloc == 0u) { xcd_barrier_complete(b.bar, b.x, nloc, nx); b.st[0] = nloc; b.st[1] = nx; }
        const unsigned old = xb_add(&w[XS_XCNT(b.x)], 1u);
        if (old + 1u == nloc) {
            __builtin_amdgcn_fence(__ATOMIC_RELEASE, "agent");
            asm volatile("s_waitcnt vmcnt(0)" ::: "memory");
            xb_add(&w[XS_TOP], 1u);
        }
    }
}
__device__ __forceinline__ void split_wait(const XcdBarrier& b, unsigned* w, int tid) {
    if (b.st == nullptr) return;
    if (tid == 0) {
        const unsigned nx = b.st[1];
        XB_SPIN(xb_ld(&w[XS_TOP]) < nx, b.bar);
        __builtin_amdgcn_fence(__ATOMIC_ACQUIRE, "agent");
        asm volatile("s_waitcnt vmcnt(0)" ::: "memory");
    }
    __syncthreads();
}

struct Args { const float* in[23]; float* out; unsigned char* ws; int ph_lo, ph_hi; int probe_mask, pad; };
struct Frame {
    LAS unsigned char* lds;
    int tid, lane, wave, G, vcu;
    const Args* a; float* out; unsigned char* ws;
};
__device__ __forceinline__ int mod_index(int row) { return row < SEQ ? 0 : (row < ML ? 1 : 2); }
__device__ __forceinline__ float* xrow_ptr(const Frame& F, int row) { return row < ML ? F.out + (size_t)row * D : (float*)(F.ws + WS_CX) + (size_t)(row - ML) * D; }

template <bool BIAS>
__device__ __forceinline__ void transpose_item(const float* W, int K, int N, bf16_t* WT, int kb, int n0, int vrow0, LAS float* scr, int lane,
                                               const float* sh  , float* biasp, int ldb) {
    const int k0 = 64 * kb;
    float tv[32];
#pragma unroll
    for (int i = 0; i < 32; ++i) tv[i] = W[(size_t)(k0 + 2 * i + (lane >> 5)) * N + n0 + (lane & 31)];
#pragma unroll
    for (int i = 0; i < 32; ++i) scr[(2 * i + (lane >> 5)) * 33 + (lane & 31)] = tv[i];
    if (BIAS) { scr[64 * 33 + lane] = sh[k0 + lane]; scr[64 * 33 + 64 + lane] = sh[NMOD + k0 + lane]; scr[64 * 33 + 128 + lane] = sh[2 * NMOD + k0 + lane]; }
    LDS_WAIT(); asm volatile("" ::: "memory");
    const int c = lane & 7;
#pragma unroll
    for (int j = 0; j < 4; ++j) { const int n = (lane >> 3) + 8 * j; const LAS float* s = scr + (8 * c) * 33 + n;
        u32x4 o; o.x = pk2(s[0 * 33], s[1 * 33]); o.y = pk2(s[2 * 33], s[3 * 33]); o.z = pk2(s[4 * 33], s[5 * 33]); o.w = pk2(s[6 * 33], s[7 * 33]);
        *(GAS u32x4*)(WT + (size_t)(vrow0 + n) * K + k0 + 8 * c) = o; }
    if (BIAS) {
        const int n = lane & 31, hf = lane >> 5; float p0 = 0.f, p1 = 0.f, p2 = 0.f;
#pragma unroll 8
        for (int i = 0; i < 32; ++i) { const int kk = hf * 32 + i; const float w = scr[kk * 33 + n]; p0 += scr[64 * 33 + kk] * w; p1 += scr[64 * 33 + 64 + kk] * w; p2 += scr[64 * 33 + 128 + kk] * w; }
        p0 += __shfl_xor(p0, 32); p1 += __shfl_xor(p1, 32); p2 += __shfl_xor(p2, 32);
        if (lane < 32) { __hip_atomic_store(biasp + (size_t)(kb * 3 + 0) * ldb + vrow0 + n, p0, RLX_AGENT); __hip_atomic_store(biasp + (size_t)(kb * 3 + 1) * ldb + vrow0 + n, p1, RLX_AGENT); __hip_atomic_store(biasp + (size_t)(kb * 3 + 2) * ldb + vrow0 + n, p2, RLX_AGENT); }
    }
    LDS_WAIT(); asm volatile("" ::: "memory");
}
__device__ __forceinline__ __amdgpu_buffer_rsrc_t coh_rsrc(const void* p) { return __builtin_amdgcn_make_buffer_rsrc((void*)p, 0, 0x7ffffff0, 0x00020000); }
__device__ __forceinline__ float coh_load_f32(__amdgpu_buffer_rsrc_t rs, unsigned voff, unsigned soff) { return __builtin_bit_cast(float, (unsigned)__builtin_amdgcn_raw_buffer_load_b32(rs, voff, soff, 16)); }
__device__ __forceinline__ f32x4 coh_load_f32x4(__amdgpu_buffer_rsrc_t rs, unsigned voff, unsigned soff) { return __builtin_bit_cast(f32x4, __builtin_amdgcn_raw_buffer_load_b128(rs, voff, soff, 16)); }
__device__ __forceinline__ void bias_finish(unsigned* cnt, const float* biasp, int ldb, int vrow0, float* bias  , int lane) {
    VM_WAIT();
    unsigned old = 0;
    if (lane == 0) old = __hip_atomic_fetch_add(cnt, 1u, RLX_AGENT);
    old = __builtin_amdgcn_readfirstlane(old);
    if ((old & 15u) == 15u) {
        if (lane < 32) {
            const __amdgpu_buffer_rsrc_t rs = coh_rsrc(biasp);
            float v[3][16];
#pragma unroll
            for (int j = 0; j < 3; ++j)
#pragma unroll
                for (int kb = 0; kb < 16; ++kb) v[j][kb] = coh_load_f32(rs, (unsigned)lane * 4u, (unsigned)((kb * 3 + j) * ldb + vrow0) * 4u);
#pragma unroll
            for (int j = 0; j < 3; ++j) { float s = 0.f;
#pragma unroll
                for (int kb = 0; kb < 16; ++kb) s += v[j][kb];
                bias[(size_t)j * ldb + vrow0 + lane] = s; }
        }
    }
}
__device__ __forceinline__ int vcol_in(int n) {
    if (n < 5120 || n >= 7168) return n;
    const int isb = n >= 6144, c = n - (isb ? 6144 : 5120), t = c >> 7;
    return 5120 + t * 256 + isb * 128 + (c & 127);
}
enum { CV_HG = 1, CV_CV = 2, CV_OUT = 4, CV_DOWN = 8, CV_IN = 16  , CV_UP = 32, CV_IN2 = 64   };
__device__ __forceinline__ void convert_weights(const Frame& F, int l, int mask, int first_cu = 0) {
    LAS float* scr = (LAS float*)(F.lds + F.wave * 16384);
    if ((int)blockIdx.x < first_cu) return;
    const int gw = first_cu ? ((int)blockIdx.x - first_cu) * NWAVES + F.wave : F.vcu * NWAVES + F.wave, NGW = (F.G - first_cu) * NWAVES;
    bf16_t* Wb = (bf16_t*)(F.ws + WS_W);
    const float* modf = (const float*)(F.ws + WS_MOD) + (size_t)l * 3 * NMOD;
    constexpr int I_SQ = 16 * 32, I_DN = 44 * 32, I_IN1 = 16 * 128, I_IN2 = 16 * 160, I_UP = 16 * 176;
    const int n_hg = (mask & CV_HG) ? I_SQ : 0, n_cv = (mask & CV_CV) ? I_SQ : 0, n_out = (mask & CV_OUT) ? I_SQ : 0, n_dn = (mask & CV_DOWN) ? I_DN : 0,
              n_in1 = (mask & CV_IN) ? I_IN1 : 0, n_in = n_in1 + ((mask & CV_IN2) ? I_IN2 : 0), n_up = (mask & CV_UP) ? I_UP : 0;
    const int total = n_hg + n_cv + n_out + n_dn + n_in + n_up;
    for (int it = gw; it < total; it += NGW) {
        int r = it;
        if (r < n_in) {
            const int ncb = n_in / 16, kb = r / ncb, cb = r % ncb + ((mask & CV_IN) ? 0 : I_IN1 / 16), n0 = cb * 32, v0 = vcol_in(n0);
            transpose_item<true>(F.a->in[7] + (size_t)l * D * PIN, D, PIN, Wb + WO_IN / 2, kb, n0, v0, scr, F.lane, modf + 0 * D  , (float*)(F.ws + WS_BIASP), PIN);
            bias_finish((unsigned*)(F.ws + WS_CTL) + CW_CNT_IN + l * 288 + cb, (const float*)(F.ws + WS_BIASP), PIN, v0, (float*)(F.ws + WS_BIASIN) + (size_t)l * 3 * PIN, F.lane);
            continue; } r -= n_in;
        if (r < n_up) {
            const int kb = r / 176, cb = r % 176, n0 = cb * 32;
            transpose_item<true>(F.a->in[18] + (size_t)l * D * NUP, D, NUP, Wb + WO_UP / 2, kb, n0, n0, scr, F.lane, modf + 3 * D  , (float*)(F.ws + WS_BIASP2), NUP);
            bias_finish((unsigned*)(F.ws + WS_CTL) + CW_CNT_UP + l * 176 + cb, (const float*)(F.ws + WS_BIASP2), NUP, n0, (float*)(F.ws + WS_BIASUP) + (size_t)l * 3 * NUP, F.lane);
            continue; } r -= n_up;
        if (r < n_hg) { transpose_item<false>(F.a->in[10] + (size_t)l * D * D, D, D, Wb + WO_HG / 2, r / 32, (r % 32) * 32, (r % 32) * 32, scr, F.lane, nullptr, nullptr, 0); continue; } r -= n_hg;
        if (r < n_cv) { transpose_item<false>(F.a->in[15] + (size_t)l * D * D, D, D, Wb + WO_CV / 2, r / 32, (r % 32) * 32, (r % 32) * 32, scr, F.lane, nullptr, nullptr, 0); continue; } r -= n_cv;
        if (r < n_out) { transpose_item<false>(F.a->in[16] + (size_t)l * D * D, D, D, Wb + WO_OUT / 2, r / 32, (r % 32) * 32, (r % 32) * 32, scr, F.lane, nullptr, nullptr, 0); continue; } r -= n_out;
        transpose_item<false>(F.a->in[21] + (size_t)l * FFN * D, FFN, D, Wb + WO_DOWN / 2, r / 32, (r % 32) * 32, (r % 32) * 32, scr, F.lane, nullptr, nullptr, 0);
    }
}

__device__ __forceinline__ void mod_gemv(const Frame& F) {
    const int gw = F.vcu * NWAVES + F.wave, NGW = F.G * NWAVES, lane = F.lane;
    float* modp = (float*)(F.ws + WS_MODP); float* modf = (float*)(F.ws + WS_MOD);
    for (int it = gw; it < 2 * 24 * 16; it += NGW) {
        const int l = it / 384, r = it % 384, cg = r / 16, ks = r % 16, k0 = 64 * ks;
        const float c0 = F.a->in[1][k0 + lane], c1 = F.a->in[1][D + k0 + lane], c2 = F.a->in[3][k0 + lane];
        const float s0 = siluf_(c0), s1 = siluf_(c1), s2 = siluf_(c2);
        const float* Wp = F.a->in[4] + ((size_t)l * D + k0) * NMOD + cg * 256 + lane * 4;
        f32x4 a0 = {0.f, 0.f, 0.f, 0.f}, a1 = a0, a2 = a0;
#pragma unroll 16
        for (int kk = 0; kk < 64; ++kk) {
            const f32x4 w = *(const f32x4*)(Wp + (size_t)kk * NMOD);
            a0 += __shfl(s0, kk) * w; a1 += __shfl(s1, kk) * w; a2 += __shfl(s2, kk) * w;
        }
        const size_t po = ((size_t)(l * 16 + ks) * 3) * NMOD + cg * 256 + lane * 4;
#pragma unroll
        for (int q = 0; q < 4; ++q) { __hip_atomic_store(modp + po + q, a0[q], RLX_AGENT); __hip_atomic_store(modp + po + NMOD + q, a1[q], RLX_AGENT); __hip_atomic_store(modp + po + 2 * NMOD + q, a2[q], RLX_AGENT); }
        VM_WAIT();
        unsigned old = 0;
        if (lane == 0) old = __hip_atomic_fetch_add((unsigned*)(F.ws + WS_CTL) + CW_CNT_MOD + l * 24 + cg, 1u, RLX_AGENT);
        old = __builtin_amdgcn_readfirstlane(old);
        if ((old & 15u) == 15u) {
            const f32x4 bm = *(const f32x4*)(F.a->in[5] + (size_t)l * NMOD + cg * 256 + lane * 4);
            const __amdgpu_buffer_rsrc_t rs = coh_rsrc(modp);
#pragma unroll
            for (int j = 0; j < 3; ++j) { f32x4 s = bm; f32x4 v[16];
#pragma unroll
                for (int k2 = 0; k2 < 16; ++k2) v[k2] = coh_load_f32x4(rs, (unsigned)lane * 16u, (unsigned)(((l * 16 + k2) * 3 + j) * NMOD + cg * 256) * 4u);
#pragma unroll
                for (int k2 = 0; k2 < 16; ++k2) s += v[k2];
                *(f32x4*)(modf + ((size_t)l * 3 + j) * NMOD + cg * 256 + lane * 4) = s; }
        }
    }
}

__device__ __forceinline__ void xb_init(const Frame& F) {
    const int gw = F.vcu * NWAVES + F.wave, NGW = F.G * NWAVES, lane = F.lane;
    const float* modf = (const float*)(F.ws + WS_MOD);
    bf16_t* xb = (bf16_t*)F.out; float* ssq = (float*)(F.ws + WS_SSQ);
    f32x4 pw[3][4];
#pragma unroll
    for (int q = 0; q < 4; ++q) {
        const f32x4 nw = *(const f32x4*)(F.a->in[6] + 256 * q + 4 * lane);
#pragma unroll
        for (int j = 0; j < 3; ++j) pw[j][q] = nw * (*(const f32x4*)(modf + (size_t)j * NMOD + D + 256 * q + 4 * lane) + 1.0f);
    }
    for (int row0 = gw; row0 < MT; row0 += 4 * NGW) {
        f32x4 v[4][4];
#pragma unroll
        for (int k = 0; k < 4; ++k) {
            const int row = row0 + k * NGW;
            if (row < MT) {
                const float* src = row < ML ? F.a->in[0] + (size_t)row * D : F.a->in[2] + (size_t)(row - ML) * D;
#pragma unroll
                for (int q = 0; q < 4; ++q) v[k][q] = *(const f32x4*)(src + 256 * q + 4 * lane);
            }
        }
#pragma unroll
        for (int k = 0; k < 4; ++k) {
            const int row = row0 + k * NGW;
            if (row < MT) {
                const int j = mod_index(row);
                float s = 0.f;
#pragma unroll
                for (int q = 0; q < 4; ++q) {
                    const int c = 256 * q + 4 * lane;
                    s += (v[k][q].x * v[k][q].x + v[k][q].y * v[k][q].y) + (v[k][q].z * v[k][q].z + v[k][q].w * v[k][q].w);
                    const f32x4 pj = j == 0 ? pw[0][q] : (j == 1 ? pw[1][q] : pw[2][q]);
                    const f32x4 o = v[k][q] * pj;
                    u32x2 w; w.x = pk2(o.x, o.y); w.y = pk2(o.z, o.w);
                    *(u32x2*)(xb + (size_t)row * D + c) = w;
                }
                s = wave_sum(s);
                if (lane < 16) ssq[(size_t)row * 16 + lane] = lane == 0 ? s : 0.f;
            }
        }
    }
}

struct EpiCommon {
    __device__ static __forceinline__ float rstd_of(const float* ssq, int row) {
        const f32x4 a = *(const f32x4*)(ssq + (size_t)row * 16), b = *(const f32x4*)(ssq + (size_t)row * 16 + 4), c = *(const f32x4*)(ssq + (size_t)row * 16 + 8), d = *(const f32x4*)(ssq + (size_t)row * 16 + 12);
        const float s = ((a.x + a.y) + (a.z + a.w)) + ((b.x + b.y) + (b.z + b.w)) + ((c.x + c.y) + (c.z + c.w)) + ((d.x + d.y) + (d.z + d.w));
        return rsqrtf_(s * (1.0f / D) + EPS);
    }
    template <class Order>
    __device__ static __forceinline__ void rstd_prologue(const float* ssq, const Order& S, int tid) {
        LAS float* rsl = (LAS float*)((LAS unsigned char*)0 + pg8::STAGE_BYTES);
        const int wv = __builtin_amdgcn_readfirstlane(tid >> 8), r = tid & 255;
        float rs[4]; bool ok[4];
#pragma unroll
        for (int k = 0; k < 4; ++k) { pg8::Unit u; ok[k] = S.next(2 * k + wv, u); rs[k] = ok[k] ? rstd_of(ssq, u.pm * 256 + r) : 0.f; }
#pragma unroll
        for (int k = 0; k < 4; ++k) if (ok[k]) rsl[(2 * k + wv) * 256 + r] = rs[k];
        asm volatile("s_waitcnt lgkmcnt(0)" ::: "memory");
        __syncthreads();
    }
    __device__ static __forceinline__ const LAS float* rstd_slot(const float* ssq, const pg8::Unit& u, int wr, int wc, int fr, int fq) {
        if (u.ui >= 0) return (LAS float*)((LAS unsigned char*)0 + pg8::STAGE_BYTES) + u.ui * 256 + wr * 64 + fr;
        return rstd_tile(ssq, u.pm * 256, wr, wc, fr, fq);
    }
    __device__ static __forceinline__ const LAS float* rstd_tile(const float* ssq, int row0, int wr, int wc, int fr, int fq) {
        LAS float* rsl = (LAS float*)((LAS unsigned char*)0 + pg8::STAGE_BYTES);
        const int tid = (wr * 4 + wc) * 64 + fq * 16 + fr;
        __builtin_amdgcn_s_barrier();
        if (tid < 256) rsl[tid] = rstd_of(ssq, row0 + tid);
        asm volatile("s_waitcnt lgkmcnt(0)" ::: "memory");
        __builtin_amdgcn_s_barrier();
        return rsl + wr * 64 + fr;
    }
};
struct EpiG1 {
    const float* ssq; const float* bias;
    bf16_t* QV; unsigned short* Ff; unsigned short* Fb;
    template <int NA, int NM> __device__ __forceinline__ void operator()(const f32x4 (&acc)[NA][2][NM][2], const pg8::Unit& u, int ro, int wr, int wc, int fr, int fq) const {
        const int j = u.pm < 32 ? 0 : (u.pm < 64 ? 1 : 2), type = u.pn >> 2;
        const int colt = u.pn * 256 + wc * 32 + 8 * fq;
        const LAS float* rsl = EpiCommon::rstd_slot(ssq, u, wr, wc, fr, fq);
        f32x4 bv[2][2];
#pragma unroll
        for (int bj = 0; bj < 2; ++bj)
#pragma unroll
            for (int n = 0; n < 2; ++n) bv[bj][n] = *(const f32x4*)(bias + (size_t)j * PIN + colt + bj * 128 + 4 * n);
#pragma unroll
        for (int ai = 0; ai < NA; ++ai)
#pragma unroll
            for (int m = 0; m < NM; ++m) {
                const int row = u.pm * 256 + ro + ai * 128 + wr * 64 + m * 16 + fr;
                const float rs = rsl[ro + ai * 128 + m * 16];
#pragma unroll
                for (int bj = 0; bj < 2; ++bj) {
                    const f32x4 v0 = acc[ai][bj][m][0] * rs + bv[bj][0], v1 = acc[ai][bj][m][1] * rs + bv[bj][1];
                    const int c = colt + bj * 128;
                    u32x4 w;
                    if (type == 1 || type == 2) {
                        f32x4 c0, c1;
                        c0.x = __builtin_amdgcn_rcpf(1.0f + __builtin_amdgcn_exp2f(v0.x * 1.4426950408889634f)); c0.y = __builtin_amdgcn_rcpf(1.0f + __builtin_amdgcn_exp2f(v0.y * 1.4426950408889634f));
                        c0.z = __builtin_amdgcn_rcpf(1.0f + __builtin_amdgcn_exp2f(v0.z * 1.4426950408889634f)); c0.w = __builtin_amdgcn_rcpf(1.0f + __builtin_amdgcn_exp2f(v0.w * 1.4426950408889634f));
                        c1.x = __builtin_amdgcn_rcpf(1.0f + __builtin_amdgcn_exp2f(v1.x * 1.4426950408889634f)); c1.y = __builtin_amdgcn_rcpf(1.0f + __builtin_amdgcn_exp2f(v1.y * 1.4426950408889634f));
                        c1.z = __builtin_amdgcn_rcpf(1.0f + __builtin_amdgcn_exp2f(v1.z * 1.4426950408889634f)); c1.w = __builtin_amdgcn_rcpf(1.0f + __builtin_amdgcn_exp2f(v1.w * 1.4426950408889634f));
                        w.x = pkh2(c0.x, c0.y); w.y = pkh2(c0.z, c0.w); w.z = pkh2(c1.x, c1.y); w.w = pkh2(c1.z, c1.w);
                        unsigned short* dst = (type == 1 ? Ff : Fb) + (size_t)row * D + (c - type * 1024);
                        *(u32x4*)dst = w;
                    } else {
                        w.x = pk2(v0.x, v0.y); w.y = pk2(v0.z, v0.w); w.z = pk2(v1.x, v1.y); w.w = pk2(v1.z, v1.w);
                        bf16_t* dst = QV + (size_t)row * 2048 + (type == 0 ? c : 1024 + (c - 3072));
                        *(u32x4*)dst = w;
                    }
                }
            }
    }
};
struct EpiG2 {
    const float* ssq; const float* bias;
    bf16_t* QV; bf16_t* U; bf16_t* SGH; bf16_t* SGC; bool dry;
    template <int NA, int NM> __device__ __forceinline__ void operator()(const f32x4 (&acc)[NA][2][NM][2], const pg8::Unit& u, int ro, int wr, int wc, int fr, int fq) const {
        const int j = u.pm < 32 ? 0 : (u.pm < 64 ? 1 : 2);
        const int colt = 4096 + u.pn * 256 + wc * 32 + 8 * fq;
        const LAS float* rsl = EpiCommon::rstd_slot(ssq, u, wr, wc, fr, fq);
        f32x4 bv[2][2];
#pragma unroll
        for (int bj = 0; bj < 2; ++bj)
#pragma unroll
            for (int n = 0; n < 2; ++n) bv[bj][n] = *(const f32x4*)(bias + (size_t)j * PIN + colt + bj * 128 + 4 * n);
#pragma unroll
        for (int ai = 0; ai < NA; ++ai)
#pragma unroll
            for (int m = 0; m < NM; ++m) {
                const int row = u.pm * 256 + ro + ai * 128 + wr * 64 + m * 16 + fr;
                const float rs = rsl[ro + ai * 128 + m * 16];
                f32x4 v[2][2];
#pragma unroll
                for (int bj = 0; bj < 2; ++bj) { v[bj][0] = acc[ai][bj][m][0] * rs + bv[bj][0]; v[bj][1] = acc[ai][bj][m][1] * rs + bv[bj][1]; }
                if (u.pn < 4) {
#pragma unroll
                    for (int bj = 0; bj < 2; ++bj) {
                        bf16_t* p = QV + (size_t)row * 2048 + (colt - 4096) + bj * 128;
                        const u32x4 on = *(const u32x4*)p;
                        u32x4 w;
                        w.x = pk2(bflo(on.x) * siluf_(v[bj][0].x), bfhi(on.x) * siluf_(v[bj][0].y)); w.y = pk2(bflo(on.y) * siluf_(v[bj][0].z), bfhi(on.y) * siluf_(v[bj][0].w));
                        w.z = pk2(bflo(on.z) * siluf_(v[bj][1].x), bfhi(on.z) * siluf_(v[bj][1].y)); w.w = pk2(bflo(on.w) * siluf_(v[bj][1].z), bfhi(on.w) * siluf_(v[bj][1].w));
                        if (!dry) *(u32x4*)p = w; else asm volatile("" :: "v"(w));
                    }
                } else if (u.pn < 12) {
                    const int t = u.pn - 4;
                    const f32x4 a0 = v[0][0], a1 = v[0][1], b0 = v[1][0], b1 = v[1][1];
                    u32x4 w;
                    w.x = pk2(a0.x * sigmoidf_(b0.x), a0.y * sigmoidf_(b0.y)); w.y = pk2(a0.z * sigmoidf_(b0.z), a0.w * sigmoidf_(b0.w));
                    w.z = pk2(a1.x * sigmoidf_(b1.x), a1.y * sigmoidf_(b1.y)); w.w = pk2(a1.z * sigmoidf_(b1.z), a1.w * sigmoidf_(b1.w));
                    *(u32x4*)(U + (size_t)row * D + t * 128 + wc * 32 + 8 * fq) = w;
                } else {
                    bf16_t* base = (u.pn < 16 ? SGH : SGC) + (size_t)row * D + ((u.pn & 3) * 256 + wc * 32 + 8 * fq);
#pragma unroll
                    for (int bj = 0; bj < 2; ++bj) {
                        u32x4 w;
                        w.x = pk2(sigmoidf_(v[bj][0].x), sigmoidf_(v[bj][0].y)); w.y = pk2(sigmoidf_(v[bj][0].z), sigmoidf_(v[bj][0].w));
                        w.z = pk2(sigmoidf_(v[bj][1].x), sigmoidf_(v[bj][1].y)); w.w = pk2(sigmoidf_(v[bj][1].z), sigmoidf_(v[bj][1].w));
                        *(u32x4*)(base + bj * 128) = w;
                    }
                }
            }
    }
};
template <int PASS> struct EpiY {
    const bf16_t* SG; bf16_t* Y; const bf16_t* T;
    template <int NA, int NM> __device__ __forceinline__ void operator()(const f32x4 (&acc)[NA][2][NM][2], const pg8::Unit& u, int ro, int wr, int wc, int fr, int fq) const {
        const int colt = u.pn * 256 + wc * 32 + 8 * fq;
#pragma unroll
        for (int ai = 0; ai < NA; ++ai) {
#pragma unroll
            for (int mp = 0; mp < NM; mp += 2) {
            u32x4 g[4][2], t[4][2];
#pragma unroll
            for (int m = mp; m < (NM < 2 ? NM : mp + 2); ++m)
#pragma unroll
                for (int bj = 0; bj < 2; ++bj) {
                    const size_t o = (size_t)(u.pm * 256 + ro + ai * 128 + wr * 64 + m * 16 + fr) * D + colt + bj * 128;
                    g[m][bj] = *(const u32x4*)(SG + o);
                    if (PASS == 2) t[m][bj] = *(const u32x4*)(T + o);
                }
#pragma unroll
            for (int m = mp; m < (NM < 2 ? NM : mp + 2); ++m)
#pragma unroll
                for (int bj = 0; bj < 2; ++bj) {
                    const size_t o = (size_t)(u.pm * 256 + ro + ai * 128 + wr * 64 + m * 16 + fr) * D + colt + bj * 128;
                    const u32x4 gg = g[m][bj];
                    f32x4 v0 = acc[ai][bj][m][0], v1 = acc[ai][bj][m][1];
                    v0.x *= bflo(gg.x); v0.y *= bfhi(gg.x); v0.z *= bflo(gg.y); v0.w *= bfhi(gg.y);
                    v1.x *= bflo(gg.z); v1.y *= bfhi(gg.z); v1.z *= bflo(gg.w); v1.w *= bfhi(gg.w);
                    if (PASS == 2) { const u32x4 tt = t[m][bj];
                        v0.x += bflo(tt.x); v0.y += bfhi(tt.x); v0.z += bflo(tt.y); v0.w += bfhi(tt.y);
                        v1.x += bflo(tt.z); v1.y += bfhi(tt.z); v1.z += bflo(tt.w); v1.w += bfhi(tt.w); }
                    u32x4 w; w.x = pk2(v0.x, v0.y); w.y = pk2(v0.z, v0.w); w.z = pk2(v1.x, v1.y); w.w = pk2(v1.z, v1.w);
                    *(u32x4*)(Y + o) = w;
                }
            }
        }
    }
};
struct EpiRes {
    const float* slat; const float* sctx;
    bf16_t* xr; const float* gate  ; const float* nw  ; const float* nsc  ;
    bf16_t* xb; float* ssq; bool dry;
    template <int NA, int NM> __device__ __forceinline__ void operator()(const f32x4 (&acc)[NA][2][NM][2], const pg8::Unit& u, int ro, int wr, int wc, int fr, int fq) const {
        const int j = u.pm < 32 ? 0 : (u.pm < 64 ? 1 : 2);
        const int colt = u.pn * 256 + wc * 32 + 8 * fq;
        LAS f32x4* cs = (LAS f32x4*)((LAS unsigned char*)0 + pg8::STAGE_BYTES) + ((wr * 4 + wc) * 4 + fq) * 8;
#pragma unroll
        for (int bj = 0; bj < 2; ++bj)
#pragma unroll
            for (int n = 0; n < 2; ++n) {
                const f32x4 gvv = *(const f32x4*)(gate + (size_t)j * NMOD + colt + bj * 128 + 4 * n);
                f32x4 svv = (f32x4){0.f, 0.f, 0.f, 0.f};
                if (nw) svv = *(const f32x4*)(nw + colt + bj * 128 + 4 * n) * (*(const f32x4*)(nsc + (size_t)j * NMOD + colt + bj * 128 + 4 * n) + 1.0f);
                if (fr == 0) { cs[bj * 2 + n] = gvv; cs[4 + bj * 2 + n] = svv; }
            }
#pragma unroll
        for (int ai = 0; ai < NA; ++ai)
#pragma unroll
            for (int mp = 0; mp < NM; mp += 2) {
                constexpr int MB = NM < 2 ? NM : 2;
                f32x4 xv[MB][2][2];
#pragma unroll
                for (int mi = 0; mi < MB; ++mi) {
                    const int row = u.pm * 256 + ro + ai * 128 + wr * 64 + (mp + mi) * 16 + fr;
                    if (slat) {
                        const float* xs = (row < ML ? slat + (size_t)row * D : sctx + (size_t)(row - ML) * D) + colt;
#pragma unroll
                        for (int bj = 0; bj < 2; ++bj) { xv[mi][bj][0] = *(const f32x4*)(xs + bj * 128); xv[mi][bj][1] = *(const f32x4*)(xs + bj * 128 + 4); }
                    } else {
#pragma unroll
                        for (int bj = 0; bj < 2; ++bj) { const u32x4 xw = *(const u32x4*)(xr + (size_t)row * D + colt + bj * 128);
                            const f32x2 h0 = unpkh2(xw.x), h1 = unpkh2(xw.y), h2 = unpkh2(xw.z), h3 = unpkh2(xw.w);
                            xv[mi][bj][0] = (f32x4){h0.x, h0.y, h1.x, h1.y}; xv[mi][bj][1] = (f32x4){h2.x, h2.y, h3.x, h3.y}; }
                    }
                }
                asm volatile("" ::: "memory");
#pragma unroll
                for (int mi = 0; mi < MB; ++mi) {
                    const int m = mp + mi;
                    const int row = u.pm * 256 + ro + ai * 128 + wr * 64 + m * 16 + fr;
                    float s = 0.f;
#pragma unroll
                    for (int bj = 0; bj < 2; ++bj) {
                        f32x4 x0 = xv[mi][bj][0], x1 = xv[mi][bj][1];
                        x0 += cs[bj * 2] * acc[ai][bj][m][0]; x1 += cs[bj * 2 + 1] * acc[ai][bj][m][1];
                        { u32x4 xw; xw.x = pkh2(x0.x, x0.y); xw.y = pkh2(x0.z, x0.w); xw.z = pkh2(x1.x, x1.y); xw.w = pkh2(x1.z, x1.w);
                          if (!dry) *(u32x4*)(xr + (size_t)row * D + colt + bj * 128) = xw; else asm volatile("" :: "v"(xw)); }
                        s += ((x0.x * x0.x + x0.y * x0.y) + (x0.z * x0.z + x0.w * x0.w)) + ((x1.x * x1.x + x1.y * x1.y) + (x1.z * x1.z + x1.w * x1.w));
                        if (nw) { const f32x4 o0 = x0 * cs[4 + bj * 2], o1 = x1 * cs[4 + bj * 2 + 1];
                            u32x4 w; w.x = pk2(o0.x, o0.y); w.y = pk2(o0.z, o0.w); w.z = pk2(o1.x, o1.y); w.w = pk2(o1.z, o1.w);
                            if (!dry) *(u32x4*)(xb + (size_t)row * D + colt + bj * 128) = w; else asm volatile("" :: "v"(w)); }
                    }
                    s += __shfl_xor(s, 16); s += __shfl_xor(s, 32);
                    if (fq == 0 && !dry) ssq[(size_t)row * 16 + u.pn * 4 + wc] = s;
                }
            }
    }
};
struct EpiFinal {
    const bf16_t* xr; float* xio  ; const float* gate  ; const float* fnw; float* ssq; unsigned* cnt  ;
    __device__ __forceinline__ void operator()(f32x4 (&acc)[2][2][4][2], const pg8::Unit& u, int  , int wr, int wc, int fr, int fq) const {
        const int j = u.pm < 32 ? 0 : 1;
        const int colt = u.pn * 256 + wc * 32 + 8 * fq;
        f32x4 gv[2][2];
#pragma unroll
        for (int bj = 0; bj < 2; ++bj)
#pragma unroll
            for (int n = 0; n < 2; ++n) gv[bj][n] = *(const f32x4*)(gate + (size_t)j * NMOD + colt + bj * 128 + 4 * n);
#pragma unroll
        for (int ai = 0; ai < 2; ++ai)
#pragma unroll
            for (int m = 0; m < 4; ++m) {
                const int row = u.pm * 256 + ai * 128 + wr * 64 + m * 16 + fr;
                const bf16_t* xrp = xr + (size_t)row * D + colt;
                float sq = 0.f;
#pragma unroll
                for (int bj = 0; bj < 2; ++bj) {
                    const u32x4 xw = *(const u32x4*)(xrp + bj * 128);
                    const f32x2 h0 = unpkh2(xw.x), h1 = unpkh2(xw.y), h2 = unpkh2(xw.z), h3 = unpkh2(xw.w);
                    const f32x4 x0 = (f32x4){h0.x, h0.y, h1.x, h1.y} + gv[bj][0] * acc[ai][bj][m][0], x1 = (f32x4){h2.x, h2.y, h3.x, h3.y} + gv[bj][1] * acc[ai][bj][m][1];
                    acc[ai][bj][m][0] = x0; acc[ai][bj][m][1] = x1;
                    sq += ((x0.x * x0.x + x0.y * x0.y) + (x0.z * x0.z + x0.w * x0.w)) + ((x1.x * x1.x + x1.y * x1.y) + (x1.z * x1.z + x1.w * x1.w));
                }
                sq += __shfl_xor(sq, 16); sq += __shfl_xor(sq, 32);
                if (fq == 0) __hip_atomic_store(ssq + (size_t)row * 16 + u.pn * 4 + wc, sq, RLX_AGENT);
            }
        VM_WAIT();
        unsigned* c = cnt + 64 * u.pm;
        if ((threadIdx.x & 63) == 0) __hip_atomic_fetch_add(c, 1u, RLX_AGENT);
        {   unsigned spins = 0;
            while ((unsigned)__builtin_amdgcn_readfirstlane(__hip_atomic_load(c, RLX_AGENT)) < 32u && ++spins < (1u << 22)) __builtin_amdgcn_s_sleep(2);
        }
        __builtin_amdgcn_fence(__ATOMIC_ACQUIRE, "agent");
        VM_WAIT();
        f32x4 wv[2][2];
#pragma unroll
        for (int bj = 0; bj < 2; ++bj)
#pragma unroll
            for (int n = 0; n < 2; ++n) wv[bj][n] = *(const f32x4*)(fnw + colt + bj * 128 + 4 * n);
#pragma unroll
        for (int ai = 0; ai < 2; ++ai)
#pragma unroll
            for (int m = 0; m < 4; ++m) {
                const int row = u.pm * 256 + ai * 128 + wr * 64 + m * 16 + fr;
                const float rs = EpiCommon::rstd_of(ssq, row);
                float* xr = xio + (size_t)row * D + colt;
#pragma unroll
                for (int bj = 0; bj < 2; ++bj) { *(f32x4*)(xr + bj * 128) = acc[ai][bj][m][0] * rs * wv[bj][0]; *(f32x4*)(xr + bj * 128 + 4) = acc[ai][bj][m][1] * rs * wv[bj][1]; }
            }
    }
};
struct EpiUp {
    const float* ssq; const float* bias;
    bf16_t* UV;
    template <int NA, int NM> __device__ __forceinline__ void operator()(const f32x4 (&acc)[NA][2][NM][2], const pg8::Unit& u, int ro, int wr, int wc, int fr, int fq) const {
        const int j = u.pm < 32 ? 0 : (u.pm < 64 ? 1 : 2);
        const int colt = u.pn * 256 + wc * 32 + 8 * fq;
        const LAS float* rsl = EpiCommon::rstd_slot(ssq, u, wr, wc, fr, fq);
        f32x4 bv[2][2];
#pragma unroll
        for (int bj = 0; bj < 2; ++bj)
#pragma unroll
            for (int n = 0; n < 2; ++n) bv[bj][n] = *(const f32x4*)(bias + (size_t)j * NUP + colt + bj * 128 + 4 * n);
#pragma unroll
        for (int ai = 0; ai < NA; ++ai)
#pragma unroll
            for (int m = 0; m < NM; ++m) {
                const int row = u.pm * 256 + ro + ai * 128 + wr * 64 + m * 16 + fr;
                const float rs = rsl[ro + ai * 128 + m * 16];
#pragma unroll
                for (int bj = 0; bj < 2; ++bj) {
                    const f32x4 v0 = acc[ai][bj][m][0] * rs + bv[bj][0], v1 = acc[ai][bj][m][1] * rs + bv[bj][1];
                    u32x4 w; w.x = pk2(v0.x, v0.y); w.y = pk2(v0.z, v0.w); w.z = pk2(v1.x, v1.y); w.w = pk2(v1.z, v1.w);
                    *(u32x4*)(UV + (size_t)row * NUP + colt + bj * 128) = w;
                }
            }
    }
};

namespace hg {
constexpr int S128 = 272, S64 = 144;
constexpr int O_QH = 0, O_KH = O_QH + 64 * S128, O_KE = O_KH + 64 * S128, O_VT = O_KE + 128 * S64, O_ST = O_VT + 128 * S64, O_P = O_ST + 128 * S128,
              O_SEG = O_P + 64 * S64, O_CE = O_SEG + 8 * 128 * 4, O_EM = O_CE + 128 * 4, O_RMS = O_EM + 128 * 4, O_END = O_RMS + 64 * 4 * 4;
static_assert(O_END <= 131072, "hgrn lds");
constexpr float LOG2E = 1.4426950408889634f;
__device__ __forceinline__ float lb_of(const Frame& F, int l, int dir, int ch) {
    if (l == 0) return 0.f;
    const float x0 = F.a->in[8][(size_t)(dir * DEPTH + 0) * D + ch], x1 = F.a->in[8][(size_t)(dir * DEPTH + 1) * D + ch];
    return sigmoidf_(x1 - x0);
}
typedef _Float16 h2_t __attribute__((ext_vector_type(2)));
__device__ __forceinline__ __amdgpu_buffer_rsrc_t mk_rsrc(const void* p) { return __builtin_amdgcn_make_buffer_rsrc((void*)p, 0, 0x7ffffff0, 0x00020000); }
__device__ __forceinline__ void load8(unsigned (&dst)[8], __amdgpu_buffer_rsrc_t rs, unsigned lane_off_bytes, unsigned row0_off_bytes, unsigned stride_bytes) {
#pragma unroll
    for (int i = 0; i < 8; ++i) dst[i] = (unsigned)__builtin_amdgcn_raw_buffer_load_b32(rs, lane_off_bytes, row0_off_bytes + (unsigned)i * stride_bytes, 0);
}
__device__ __forceinline__ f32x2 ex2(f32x2 v) { return (f32x2){__builtin_amdgcn_exp2f(v.x), __builtin_amdgcn_exp2f(v.y)}; }
__device__ __forceinline__ f32x2 gates8(const unsigned (&rf)[8], f32x2 lb, f32x2 (&gg)[8], f32x2 (&kk)[8]) {
    const f32x2 oml = 1.0f - lb;
#pragma unroll
    for (int i = 0; i < 8; ++i) {
        const f32x2 c = __builtin_convertvector(__builtin_bit_cast(h2_t, rf[i]), f32x2);
        const f32x2 kv = oml * c;
        f32x2 g = 1.0f - kv; g.x = fmaxf(g.x, GMIN); g.y = fmaxf(g.y, GMIN);
        gg[i] = g;
        kk[i] = kv;
    }
    const f32x2 p0 = (gg[0] * gg[1]) * (gg[2] * gg[3]), p1 = (gg[4] * gg[5]) * (gg[6] * gg[7]);
    return (f32x2){__builtin_amdgcn_logf(p0.x) + __builtin_amdgcn_logf(p1.x), __builtin_amdgcn_logf(p0.y) + __builtin_amdgcn_logf(p1.y)};
}
template <int DIR>
__device__ __forceinline__ void decay8(const Frame& F, f32x2 tot, f32x2 (&gg)[8], f32x2 (&ke)[8], f32x2& cmid, f32x2& cend, f32x2 (*ie)[8] = nullptr) {
    LAS f32x2* seg = (LAS f32x2*)(F.lds + O_SEG);
    const int w = F.wave;
    seg[w * 64 + F.lane] = tot;
    __syncthreads();
    f32x2 sv[8];
#pragma unroll
    for (int k = 0; k < 8; ++k) sv[k] = seg[k * 64 + F.lane];
    const f32x2 lo4 = (sv[0] + sv[1]) + (sv[2] + sv[3]), hi4 = (sv[4] + sv[5]) + (sv[6] + sv[7]);
    cend = lo4 + hi4; cmid = DIR == 0 ? lo4 : hi4;
    f32x2 before = {0.f, 0.f}, after = {0.f, 0.f};
#pragma unroll
    for (int k = 0; k < 8; ++k) { before += (k < w) ? sv[k] : (f32x2){0.f, 0.f}; after += (k > w) ? sv[k] : (f32x2){0.f, 0.f}; }
    const f32x2 off = DIR == 0 ? before : after, outer = DIR == 0 ? after : before;
    const f32x2 a0 = off - cmid;
    f32x2 e = ex2((f32x2){fminf(a0.x, 100.f), fminf(a0.y, 100.f)}), k = ex2(outer);
    const f32x2 b0 = -(a0 + tot);
    f32x2 v = ex2((f32x2){fminf(b0.x, 100.f), fminf(b0.y, 100.f)});
    if (DIR == 0) {
        ke[7] = k;
        if (ie) (*ie)[7] = v;
#pragma unroll
        for (int i = 6; i >= 0; --i) { k *= gg[i + 1]; ke[i] = k; if (ie) { v *= gg[i + 1]; (*ie)[i] = v; } }
#pragma unroll
        for (int i = 0; i < 8; ++i) { e *= gg[i]; gg[i] = e; }
    } else {
        ke[0] = k;
        if (ie) (*ie)[0] = v;
#pragma unroll
        for (int i = 1; i < 8; ++i) { k *= gg[i - 1]; ke[i] = k; if (ie) { v *= gg[i - 1]; (*ie)[i] = v; } }
#pragma unroll
        for (int i = 7; i >= 0; --i) { e *= gg[i]; gg[i] = e; }
    }
}
__device__ __forceinline__ void write_ke_vt8(const Frame& F, const f32x2 (&kef)[8], const f32x2 (&kk)[8], const unsigned (&rv)[8], f32x2 cend) {
    LAS unsigned char* L = F.lds;
    const int w = F.wave;
    f32x2 ke[8];
#pragma unroll
    for (int i = 0; i < 8; ++i) ke[i] = kk[i] * kef[i];
    LAS unsigned char* kp = L + (2 * F.lane) * S64 + w * 16;
    *(LAS u32x4*)(kp + O_KE) = (u32x4){pk2(ke[0].x, ke[1].x), pk2(ke[2].x, ke[3].x), pk2(ke[4].x, ke[5].x), pk2(ke[6].x, ke[7].x)};
    *(LAS u32x4*)(kp + O_KE + S64) = (u32x4){pk2(ke[0].y, ke[1].y), pk2(ke[2].y, ke[3].y), pk2(ke[4].y, ke[5].y), pk2(ke[6].y, ke[7].y)};
    *(LAS u32x4*)(kp + O_VT) = (u32x4){__builtin_amdgcn_perm(rv[1], rv[0], 0x05040100u), __builtin_amdgcn_perm(rv[3], rv[2], 0x05040100u), __builtin_amdgcn_perm(rv[5], rv[4], 0x05040100u), __builtin_amdgcn_perm(rv[7], rv[6], 0x05040100u)};
    *(LAS u32x4*)(kp + O_VT + S64) = (u32x4){__builtin_amdgcn_perm(rv[1], rv[0], 0x07060302u), __builtin_amdgcn_perm(rv[3], rv[2], 0x07060302u), __builtin_amdgcn_perm(rv[5], rv[4], 0x07060302u), __builtin_amdgcn_perm(rv[7], rv[6], 0x07060302u)};
    if (w == 0) ((LAS f32x2*)(L + O_CE))[F.lane] = ex2(cend);
}
__device__ __forceinline__ void write_qh_kh8(const Frame& F, const f32x2 (&e1v)[8], const f32x2 (&iev)[8], const f32x2 (&kk)[8], const unsigned (&rq)[8], f32x2 cmid) {
    LAS unsigned char* L = F.lds;
    const int w = F.wave;
    LAS unsigned char* tp = L + (8 * w) * S128 + F.lane * 4;
#pragma unroll
    for (int i = 0; i < 8; ++i) {
        const f32x2 e1 = e1v[i];
        const f32x2 e2 = iev[i];
        const f32x2 qh = (f32x2){bflo(rq[i]), bfhi(rq[i])} * e1, kh = kk[i] * e2;
        *(LAS unsigned*)(tp + O_QH + i * S128) = pk2(qh.x, qh.y);
        *(LAS unsigned*)(tp + O_KH + i * S128) = pk2(kh.x, kh.y);
    }
    if (w == 1) ((LAS f32x2*)(L + O_EM))[F.lane] = ex2(cmid);
}
__device__ __forceinline__ void state_update(const Frame& F, f32x16 (&S)[2]) {
    LAS unsigned char* L = F.lds;
    const int w = F.wave, lane = F.lane, r = lane & 31, hh = lane >> 5, db = w >> 1;
    const LAS float* ce = (const LAS float*)(L + O_CE) + 32 * db + 4 * hh;
    float dec[16];
#pragma unroll
    for (int g = 0; g < 4; ++g) { const f32x4 t = *(const LAS f32x4*)(ce + 8 * g); dec[4 * g] = t.x; dec[4 * g + 1] = t.y; dec[4 * g + 2] = t.z; dec[4 * g + 3] = t.w; }
    const LAS unsigned char* ap = L + O_KE + (32 * db + r) * S64 + 16 * hh;
#pragma unroll
    for (int blk = 0; blk < 2; ++blk) {
        const int eb = 2 * (w & 1) + blk;
        const LAS unsigned char* bp = L + O_VT + (32 * eb + r) * S64 + 16 * hh;
#pragma unroll
        for (int i = 0; i < 16; ++i) S[blk][i] *= dec[i];
#pragma unroll
        for (int kq = 0; kq < 4; ++kq) {
            const bf16x8 a = *(const LAS bf16x8*)(ap + 32 * kq);
            const bf16x8 b = *(const LAS bf16x8*)(bp + 32 * kq);
            S[blk] = __builtin_amdgcn_mfma_f32_32x32x16_bf16(a, b, S[blk], 0, 0, 0);
        }
    }
}
__device__ __forceinline__ void write_st(const Frame& F, const f32x16 (&S)[2]) {
    LAS unsigned char* L = F.lds;
    const int w = F.wave, lane = F.lane, r = lane & 31, hh = lane >> 5, db = w >> 1;
    const LAS float* em = (const LAS float*)(L + O_EM) + 32 * db + 4 * hh;
    f32x4 sc[4];
#pragma unroll
    for (int g = 0; g < 4; ++g) sc[g] = *(const LAS f32x4*)(em + 8 * g);
#pragma unroll
    for (int blk = 0; blk < 2; ++blk) {
        const int eb = 2 * (w & 1) + blk;
        LAS unsigned char* sp = L + O_ST + (32 * eb + r) * S128 + (32 * db + 4 * hh) * 2;
#pragma unroll
        for (int g = 0; g < 4; ++g) {
            u32x2 o; o.x = pk2(S[blk][4 * g] * sc[g].x, S[blk][4 * g + 1] * sc[g].y); o.y = pk2(S[blk][4 * g + 2] * sc[g].z, S[blk][4 * g + 3] * sc[g].w);
            *(LAS u32x2*)(sp + 16 * g) = o;
        }
    }
}
}

__device__ __forceinline__ void state_store(const Frame& F, float* base  , const f32x16 (&S)[2]) {
    const int w = F.wave, lane = F.lane, r = lane & 31, hh = lane >> 5, db = w >> 1;
    unsigned* ub = (unsigned*)base + (size_t)(16 * db + 2 * hh) * 128 + r;
#pragma unroll
    for (int blk = 0; blk < 2; ++blk) { unsigned* bp = ub + 32 * (2 * (w & 1) + blk);
#pragma unroll
        for (int g = 0; g < 4; ++g) { bp[(4 * g) * 128] = pk2(S[blk][4 * g], S[blk][4 * g + 1]); bp[(4 * g + 1) * 128] = pk2(S[blk][4 * g + 2], S[blk][4 * g + 3]); } }
}
__device__ __forceinline__ void state_load(const Frame& F, const float* base, f32x16 (&S)[2]) {
    const int w = F.wave, lane = F.lane, r = lane & 31, hh = lane >> 5, db = w >> 1;
    const unsigned* ub = (const unsigned*)base + (size_t)(16 * db + 2 * hh) * 128 + r;
#pragma unroll
    for (int blk = 0; blk < 2; ++blk) { const unsigned* bp = ub + 32 * (2 * (w & 1) + blk);
#pragma unroll
        for (int g = 0; g < 4; ++g) { const unsigned w0 = bp[(4 * g) * 128], w1 = bp[(4 * g + 1) * 128];
            S[blk][4 * g] = bflo(w0); S[blk][4 * g + 1] = bfhi(w0); S[blk][4 * g + 2] = bflo(w1); S[blk][4 * g + 3] = bfhi(w1); } }
}

__device__ __forceinline__ void hgrn_a_decode(int it, int& h, int& dir, int& row0) {
    if (it < 1024) { const int j = it & 31; dir = (it >> 5) & 1; h = (it >> 6) & 7; const int b = it >> 9; row0 = b * SEQ + 256 * j; }
    else { const int q = it - 1024; dir = q & 1; h = (q >> 1) & 7; const int b = q >> 4; row0 = ML + b * CTXL; }
}
__device__ __forceinline__ void hgrn_c_decode(int it, int& h, int& row0) {
    if (it < 512) { h = (it >> 5) & 7; row0 = (it >> 8) * SEQ + 256 * (it & 31); } else { const int q = it - 512; h = q & 7; row0 = ML + (q >> 3) * CTXL; }
}
template <int DIR>
__device__ __forceinline__ void hgrn_a_item(const Frame& F, int l, int it, int h, int row0, unsigned (&rf)[8], unsigned (&rv)[8], bool pre, int itn  ) {
    const bf16_t* QV = (const bf16_t*)(F.ws + WS_QV);
    float* ST = (float*)(F.ws + WS_ST); float* DV = (float*)(F.ws + WS_DV);
    const unsigned short* Fg = (const unsigned short*)(F.ws + (DIR == 0 ? WS_S2 : WS_S3));
    const int w = F.wave;
    const f32x2 lb = {hg::lb_of(F, l, DIR, h * 128 + 2 * F.lane), hg::lb_of(F, l, DIR, h * 128 + 2 * F.lane + 1)};
    f32x16 S[2];
#pragma unroll
    for (int i = 0; i < 16; ++i) { S[0][i] = 0.f; S[1][i] = 0.f; }
    f32x2 ctot = {0.f, 0.f};
    const __amdgpu_buffer_rsrc_t rsF = hg::mk_rsrc(Fg), rsQ = hg::mk_rsrc(QV);
    const unsigned lof = (unsigned)(h * 256 + F.lane * 4);
    if (!pre) { const int rowc = row0 + 64 * (DIR == 0 ? 0 : 3) + 8 * w;
      hg::load8(rf, rsF, lof, (unsigned)rowc * 2048u, 2048u); hg::load8(rv, rsQ, lof + 2048u, (unsigned)rowc * 4096u, 4096u); }
#pragma unroll 1
    for (int cc = 0; cc < 4; ++cc) {
        int rown = row0 + 64 * (DIR == 0 ? (cc < 3 ? cc + 1 : 3) : (cc < 3 ? 2 - cc : 0)) + 8 * w;
        const unsigned short* Fx = Fg; int hx = h;
        if (cc == 3 && itn >= 0) { int nd, nr; hgrn_a_decode(itn, hx, nd, nr); rown = nr + (nd ? 192 : 0) + 8 * w; Fx = (const unsigned short*)(F.ws + (nd ? WS_S3 : WS_S2)); }
        asm volatile("" : "+s"(rown));
        const __amdgpu_buffer_rsrc_t rsFx = hg::mk_rsrc(Fx);
        const unsigned lofx = (unsigned)(hx * 256 + F.lane * 4);
        f32x2 lg[8]; f32x2 kk[8];
        const f32x2 tot = hg::gates8(rf, lb, lg, kk);
        hg::load8(rf, rsFx, lofx, (unsigned)rown * 2048u, 2048u);
        f32x2 cmid, cend;
        f32x2 kef[8];
        hg::decay8<DIR>(F, tot, lg, kef, cmid, cend);
        hg::write_ke_vt8(F, kef, kk, rv, cend);
        hg::load8(rv, rsQ, lofx + 2048u, (unsigned)rown * 4096u, 4096u);
        ctot += cend;
        __syncthreads();
        hg::state_update(F, S);
    }
    state_store(F, ST + (size_t)it * 16384, S);
    if (w == 0) ((f32x2*)(DV + (size_t)it * 128))[F.lane] = hg::ex2(ctot);
}
__device__ __forceinline__ void hgrn_phase_a(const Frame& F, int l, int ncu) {
    if ((int)blockIdx.x >= ncu) return;
    unsigned rf[8] = {}, rv[8] = {}; bool pre = false;
    for (int it = blockIdx.x; it < 1056; it += ncu) {
        int h, dir, row0; hgrn_a_decode(it, h, dir, row0);
        const int itn = it + ncu < 1056 ? it + ncu : -1;
        if (dir == 0) hgrn_a_item<0>(F, l, it, h, row0, rf, rv, pre, itn); else hgrn_a_item<1>(F, l, it, h, row0, rf, rv, pre, itn);
        pre = itn >= 0;
        __syncthreads();
    }
}
__device__ __forceinline__ void hgrn_scan(const Frame& F, bool dry) {
    unsigned* ST = (unsigned*)(F.ws + WS_ST); const float* DV = (const float*)(F.ws + WS_DV);
    const int nthreads = F.G * NTHR;
    for (int id = blockIdx.x * NTHR + F.tid; id < 32 * 64 * 32; id += nthreads) {
        const int e4 = id & 31, dp = (id >> 5) & 63, s = id >> 11;
        const int dir = s & 1;
        const u32x4 c0 = *(const u32x4*)(ST + (size_t)(1024 + s) * 16384 + dp * 128 + 4 * e4);
        f32x4 Sa = {bflo(c0.x), bflo(c0.y), bflo(c0.z), bflo(c0.w)}, Sb = {bfhi(c0.x), bfhi(c0.y), bfhi(c0.z), bfhi(c0.w)};
        unsigned* pb = ST + (size_t)s * 32 * 16384 + dp * 128 + 4 * e4; const float* dvb = DV + (size_t)s * 32 * 128 + 2 * dp;
        const int j0 = dir == 0 ? 0 : 31, js = dir == 0 ? 1 : -1;
        u32x4 uq[8]; f32x2 dq[8];
#pragma unroll
        for (int k = 0; k < 8; ++k) { const int j = j0 + js * k; uq[k] = *(const u32x4*)(pb + (size_t)j * 16384); dq[k] = *(const f32x2*)(dvb + (size_t)j * 128); }
#pragma unroll 1
        for (int jj = 0; jj < 32; jj += 8) {
#pragma unroll
            for (int k = 0; k < 8; ++k) {
                const int j = j0 + js * (jj + k);
                const u32x4 u = uq[k]; const f32x2 dv = dq[k];
                if (jj + 8 < 32) { const int jn = j + 8 * js; uq[k] = *(const u32x4*)(pb + (size_t)jn * 16384); dq[k] = *(const f32x2*)(dvb + (size_t)jn * 128); }
                if (!dry) *(u32x4*)(pb + (size_t)j * 16384) = (u32x4){pk2(Sa.x, Sb.x), pk2(Sa.y, Sb.y), pk2(Sa.z, Sb.z), pk2(Sa.w, Sb.w)};
                Sa = Sa * dv.x + (f32x4){bflo(u.x), bflo(u.y), bflo(u.z), bflo(u.w)};
                Sb = Sb * dv.y + (f32x4){bfhi(u.x), bfhi(u.y), bfhi(u.z), bfhi(u.w)};
            }
        }
    }
}
template <int DIR>
__device__ __forceinline__ void hgrn_c_dir(const Frame& F, int l, int it_lat  , int h, int row0, bf16_t* QV, unsigned* ofs  , bool dry,
                                           unsigned (&rf)[8], unsigned (&rq)[8], unsigned (&rv)[8], bool pre, int itn  ) {
    LAS unsigned char* L = F.lds;
    const int w = F.wave, lane = F.lane, tb = w >> 2, ebo = w & 3;
    const unsigned short* Fg = (const unsigned short*)(F.ws + (DIR == 0 ? WS_S2 : WS_S3));
    const f32x2 lb = {hg::lb_of(F, l, DIR, h * 128 + 2 * lane), hg::lb_of(F, l, DIR, h * 128 + 2 * lane + 1)};
    const float* ST = (const float*)(F.ws + WS_ST);
    f32x16 S[2];
    if (it_lat >= 0) state_load(F, ST + (size_t)(((it_lat >> 5) * 2 + DIR) * 32 + (it_lat & 31)) * 16384, S);
    else {
#pragma unroll
        for (int i = 0; i < 16; ++i) { S[0][i] = 0.f; S[1][i] = 0.f; }
    }
    const __amdgpu_buffer_rsrc_t rsF = hg::mk_rsrc(Fg), rsQ = hg::mk_rsrc(QV);
    const unsigned lof = (unsigned)(h * 256 + lane * 4);
    if (!pre) { const int rowc = row0 + 64 * (DIR == 0 ? 0 : 3) + 8 * w;
      hg::load8(rf, rsF, lof, (unsigned)rowc * 2048u, 2048u);
      hg::load8(rv, rsQ, lof + 2048u, (unsigned)rowc * 4096u, 4096u); hg::load8(rq, rsQ, lof, (unsigned)rowc * 4096u, 4096u); }
#pragma unroll 1
    for (int cc = 0; cc < 4; ++cc) {
        const int ch = DIR == 0 ? cc : 3 - cc, chn = DIR == 0 ? (cc < 3 ? cc + 1 : 3) : (cc < 3 ? 2 - cc : 0);
        int rowc = row0 + 64 * ch, rown = row0 + 64 * chn + 8 * w, r = lane & 31, hh = lane >> 5;
        const unsigned short* Fx = Fg; int hx = h;
        if (cc == 3) {
            if (DIR == 0) { rown = row0 + 192 + 8 * w; Fx = (const unsigned short*)(F.ws + WS_S3); }
            else if (itn >= 0) { int nr; hgrn_c_decode(itn, hx, nr); rown = nr + 8 * w; Fx = (const unsigned short*)(F.ws + WS_S2); }
        }
        asm volatile("" : "+s"(rowc), "+s"(rown));
        asm volatile("" : "+v"(r), "+v"(hh));
        const __amdgpu_buffer_rsrc_t rsFx = hg::mk_rsrc(Fx);
        const unsigned lofx = (unsigned)(hx * 256 + lane * 4);
        f32x2 lg[8]; f32x2 kk[8];
        const f32x2 tot = hg::gates8(rf, lb, lg, kk);
        hg::load8(rf, rsFx, lofx, (unsigned)rown * 2048u, 2048u);
        f32x2 cmid, cend;
        f32x2 kef[8];
        f32x2 ief[8];
        hg::decay8<DIR>(F, tot, lg, kef, cmid, cend, &ief);
        hg::write_ke_vt8(F, kef, kk, rv, cend);
        hg::load8(rv, rsQ, lofx + 2048u, (unsigned)rown * 4096u, 4096u);
        hg::write_qh_kh8(F, lg, ief, kk, rq, cmid);
        hg::load8(rq, rsQ, lofx, (unsigned)rown * 4096u, 4096u);
        __syncthreads();
        hg::write_st(F, S);
        if (w < 4) {
            const int sb = w >> 1, tbk = w & 1;
            const bool dead = DIR == 0 ? (sb == 1 && tbk == 0) : (sb == 0 && tbk == 1);
            f32x16 P;
#pragma unroll
            for (int i = 0; i < 16; ++i) P[i] = 0.f;
            if (!dead) {
                const LAS unsigned char* ap = L + hg::O_KH + (32 * sb + r) * hg::S128 + 16 * hh;
                const LAS unsigned char* bp = L + hg::O_QH + (32 * tbk + r) * hg::S128 + 16 * hh;
#pragma unroll
                for (int kq = 0; kq < 8; ++kq) {
                    const bf16x8 a = *(const LAS bf16x8*)(ap + 32 * kq);
                    const bf16x8 bb = *(const LAS bf16x8*)(bp + 32 * kq);
                    P = __builtin_amdgcn_mfma_f32_32x32x16_bf16(a, bb, P, 0, 0, 0);
                }
            }
            const int rel = 32 * (tbk - sb) + r - 4 * hh;
            LAS unsigned char* pp = L + hg::O_P + (32 * tbk + r) * hg::S64 + (32 * sb + 4 * hh) * 2;
#pragma unroll
            for (int g = 0; g < 4; ++g) {
                float v0 = P[4 * g], v1 = P[4 * g + 1], v2 = P[4 * g + 2], v3 = P[4 * g + 3];
                const int sl = 8 * g;
                if (DIR == 0) { v0 = (sl + 0 <= rel) ? v0 : 0.f; v1 = (sl + 1 <= rel) ? v1 : 0.f; v2 = (sl + 2 <= rel) ? v2 : 0.f; v3 = (sl + 3 <= rel) ? v3 : 0.f; }
                else          { v0 = (sl + 0 >= rel) ? v0 : 0.f; v1 = (sl + 1 >= rel) ? v1 : 0.f; v2 = (sl + 2 >= rel) ? v2 : 0.f; v3 = (sl + 3 >= rel) ? v3 : 0.f; }
                u32x2 o; o.x = pk2(v0, v1); o.y = pk2(v2, v3);
                *(LAS u32x2*)(pp + 16 * g) = o;
            }
        }
        __syncthreads();
        f32x16 o;
#pragma unroll
        for (int i = 0; i < 16; ++i) o[i] = 0.f;
        {   const LAS unsigned char* ap = L + hg::O_ST + (32 * ebo + r) * hg::S128 + 16 * hh;
            const LAS unsigned char* bp = L + hg::O_QH + (32 * tb + r) * hg::S128 + 16 * hh;
#pragma unroll 4
            for (int kq = 0; kq < 8; ++kq) {
                const bf16x8 a = *(const LAS bf16x8*)(ap + 32 * kq);
                const bf16x8 bb = *(const LAS bf16x8*)(bp + 32 * kq);
                o = __builtin_amdgcn_mfma_f32_32x32x16_bf16(a, bb, o, 0, 0, 0);
            }
        }
        {   const LAS unsigned char* ap = L + hg::O_VT + (32 * ebo + r) * hg::S64 + 16 * hh;
            const LAS unsigned char* bp = L + hg::O_P + (32 * tb + r) * hg::S64 + 16 * hh;
#pragma unroll
            for (int kq = 0; kq < 4; ++kq) {
                const bf16x8 a = *(const LAS bf16x8*)(ap + 32 * kq);
                const bf16x8 bb = *(const LAS bf16x8*)(bp + 32 * kq);
                o = __builtin_amdgcn_mfma_f32_32x32x16_bf16(a, bb, o, 0, 0, 0);
            }
        }
        if (cc < 3) hg::state_update(F, S);
        unsigned* ofp = ofs + ch * 4096 + F.tid;
        if (DIR == 0) {
#pragma unroll
            for (int i = 0; i < 8; ++i) { const unsigned ov = pk2(o[2 * i], o[2 * i + 1]); if (!dry) ofp[i * 512] = ov; else asm volatile("" :: "v"(ov)); }
        } else {
            float ss = 0.f;
#pragma unroll
            for (int i = 0; i < 8; ++i) { const unsigned ov = ofp[i * 512]; o[2 * i] += bflo(ov); o[2 * i + 1] += bfhi(ov); ss += o[2 * i] * o[2 * i] + o[2 * i + 1] * o[2 * i + 1]; }
            ss += __shfl_xor(ss, 32);
            LAS float* rms = (LAS float*)(L + hg::O_RMS) + (32 * tb + r) * 4;
            if (hh == 0) rms[ebo] = ss;
            __syncthreads();
            const f32x4 q4 = *(const LAS f32x4*)rms;
            const float rs = rsqrtf_(((q4.x + q4.y) + (q4.z + q4.w)) * (1.0f / HD) + EPS);
            const float* gwp = F.a->in[9] + (size_t)l * HD + 32 * ebo + 4 * hh;
            bf16_t* op = QV + (size_t)(rowc + 32 * tb) * 2048 + h * 128 + 32 * ebo;
            const unsigned loff = (unsigned)(r * 2048 + 4 * hh);
#pragma unroll
            for (int g = 0; g < 4; ++g) {
                const f32x4 gw = *(const f32x4*)(gwp + 8 * g);
                u32x2 ov; ov.x = pk2(o[4 * g] * rs * gw.x, o[4 * g + 1] * rs * gw.y); ov.y = pk2(o[4 * g + 2] * rs * gw.z, o[4 * g + 3] * rs * gw.w);
                if (!dry) *(u32x2*)(op + loff + 8 * g) = ov; else asm volatile("" :: "v"(ov));
            }
        }
    }
    __syncthreads();
}
__device__ __forceinline__ void hgrn_c_item(const Frame& F, int l, int it, int itn  , bool dry, unsigned (&rf)[8], unsigned (&rq)[8], unsigned (&rv)[8], bool& pre) {
    bf16_t* QV = (bf16_t*)(F.ws + WS_QV);
    int b, h, row0, itl;
    if (it < 512) { itl = it; const int j = it & 31; h = (it >> 5) & 7; b = it >> 8; row0 = b * SEQ + 256 * j; }
    else { itl = -1; const int q = it - 512; h = q & 7; b = q >> 3; row0 = ML + b * CTXL; }

    unsigned* ofs = itl >= 0 ? (unsigned*)(F.ws + WS_ST) + (size_t)(((itl >> 5) * 2 + 0) * 32 + (itl & 31)) * 16384 : (unsigned*)(F.ws + WS_END) + (size_t)(it - 512) * 16384;
    hgrn_c_dir<0>(F, l, itl, h, row0, QV, ofs, dry, rf, rq, rv, pre, -1);
    hgrn_c_dir<1>(F, l, itl, h, row0, QV, ofs, dry, rf, rq, rv, true, itn);
    pre = itn >= 0;
}

__device__ __forceinline__ void conv1d_phase(const Frame& F, int l, int nrows) {
    constexpr int TT = 16, NR = 48;
    const bf16_t* U = (const bf16_t*)(F.ws + WS_S2); bf16_t* QV = (bf16_t*)(F.ws + WS_QV);
    LAS unsigned char* ut = F.lds;
    LAS float* red = (LAS float*)F.lds;
    LAS float* red2 = (LAS float*)(F.lds + NR * 2048);
    LAS float* fin = red2 + 2 * TT * 32;
    const int tid = F.tid, c = 2 * tid;
    const float* wp = F.a->in[11] + (size_t)l * CONVK * D + c;
    const f32x2 cb = *(const f32x2*)(F.a->in[12] + (size_t)l * D + c), lw = *(const f32x2*)(F.a->in[13] + (size_t)l * D + c), lbv = *(const f32x2*)(F.a->in[14] + (size_t)l * D + c);
    const int srow = tid >> 7, scol = (tid & 127) * 8;
    u32x4 pre[NR / 4];
    auto load_tile = [&](int item) {
        const int r0 = item * TT;
        const int slo = r0 < ML ? (r0 / SEQ) * SEQ : ML + ((r0 - ML) / CTXL) * CTXL, shi = slo + (r0 < ML ? SEQ : CTXL);
#pragma unroll
        for (int k = 0; k < NR / 4; ++k) {
            const int rr = r0 - 15 + srow + 4 * k, rc = min(max(rr, slo), shi - 1); const unsigned msk = (unsigned)-(int)(rr == rc);
            const u32x4 v = *(const u32x4*)(U + (size_t)rc * D + scol);
            pre[k] = (u32x4){v.x & msk, v.y & msk, v.z & msk, v.w & msk};
        }
    };
    const int nI = nrows / TT, nfull = nI / F.G, ntail = nI - nfull * F.G, tbase = (F.G >= 128 && ntail <= F.G - 64) ? 64 : 0;
    auto item_of = [&](int k) -> int { if (k < nfull) return F.vcu + k * F.G; const int j = (int)blockIdx.x - tbase; return (k == nfull && j >= 0 && j < ntail) ? nfull * F.G + j : -1; };
    if (item_of(0) >= 0) load_tile(item_of(0));
    for (int k = 0; ; ++k) {
        const int it = item_of(k); if (it < 0) break;
        const int row0 = it * TT;
        __syncthreads();
#pragma unroll
        for (int k = 0; k < NR / 4; ++k) *(LAS u32x4*)(ut + (srow + 4 * k) * 2048 + scol * 2) = pre[k];
        __syncthreads();
        f32x2 y[TT];
#pragma unroll
        for (int t = 0; t < TT; ++t) y[t] = cb;
        const LAS unsigned char* up = ut + tid * 4;
        f32x2 wn[8];
#pragma unroll
        for (int j = 0; j < 8; ++j) wn[j] = *(const f32x2*)(wp + (size_t)j * D);
#pragma unroll 1
        for (int jb = 0; jb < 32; jb += 8) {
            f32x2 w[8];
#pragma unroll
            for (int j = 0; j < 8; ++j) w[j] = wn[j];
            const int jn = jb + 8 < 32 ? jb + 8 : 0;
#pragma unroll
            for (int j = 0; j < 8; ++j) wn[j] = (jn + j < CONVK) ? *(const f32x2*)(wp + (size_t)(jn + j) * D) : (f32x2){0.f, 0.f};
            const LAS unsigned char* ub = up + jb * 2048;
            f32x2 uu[TT + 7];
#pragma unroll
            for (int k = 0; k < TT + 7; ++k) { const unsigned v = *(const LAS unsigned*)(ub + k * 2048); uu[k] = (f32x2){bflo(v), bfhi(v)}; }
#pragma unroll
            for (int j = 0; j < 8; ++j) {
#pragma unroll
                for (int t = 0; t < TT; ++t) y[t] = __builtin_elementwise_fma(w[j], uu[j + t], y[t]);
            }
        }
        { const int nx_ = item_of(k + 1); load_tile(nx_ >= 0 ? nx_ : it); }
        __syncthreads();
#pragma unroll
        for (int t = 0; t < TT; ++t) { red[(2 * t) * 512 + tid] = y[t].x + y[t].y; red[(2 * t + 1) * 512 + tid] = y[t].x * y[t].x + y[t].y * y[t].y; }
        __syncthreads();
        {
#pragma unroll
            for (int rep = 0; rep < 2; ++rep) { const int o = tid + 512 * rep, st = o >> 5, part = o & 31; float sacc = 0.f;
#pragma unroll
                for (int k = 0; k < 16; ++k) sacc += red[st * 512 + part + 32 * k];
                red2[st * 32 + part] = sacc; }
        }
        __syncthreads();
        if (tid < TT) { float s1 = 0.f, s2 = 0.f;
#pragma unroll
            for (int k = 0; k < 32; ++k) { s1 += red2[(2 * tid) * 32 + ((k + tid) & 31)]; s2 += red2[(2 * tid + 1) * 32 + ((k + tid) & 31)]; }
            const float mean = s1 * (1.0f / D), var = fmaxf(s2 * (1.0f / D) - mean * mean, 0.f);
            fin[2 * tid] = mean; fin[2 * tid + 1] = rsqrtf_(var + EPS); }
        __syncthreads();
#pragma unroll
        for (int t = 0; t < TT; ++t) {
            const f32x2 mr = *(const LAS f32x2*)(fin + 2 * t);
            const float a0 = (y[t].x - mr.x) * mr.y * lw.x + lbv.x, a1 = (y[t].y - mr.x) * mr.y * lw.y + lbv.y;
            *(unsigned*)(QV + (size_t)(row0 + t) * 2048 + 1024 + c) = pk2(siluf_(a0), siluf_(a1));
        }
    }
}

__device__ __forceinline__ void conv2d_phase(const Frame& F, int l, bool with_ctx, bool dry) {
    bf16_t* UV = (bf16_t*)(F.ws + WS_UV);
    const float* W9 = F.a->in[19] + (size_t)l * 9 * FFN; const float* Bc = F.a->in[20] + (size_t)l * FFN;
    const int gw = F.vcu * NWAVES + F.wave, NGW = F.G * NWAVES, lane = F.lane;
    constexpr int NLAT = BATCH * (SEQ / 8) * 11, NCTX = BATCH * (CTXL / 8) * 11;
    const int total = NLAT + (with_ctx ? NCTX : 0);
    for (int it = gw; it < total; it += NGW) {
        const bool isctx = it >= NLAT;
        const int q = isctx ? it - NLAT : it, cc = q % 11, seg = q / 11;
        int tok0, c0, wlim; bool up_ok, dn_ok;
        if (!isctx) { const int b = seg >> 10, r = (seg >> 3) & 127; c0 = (seg & 7) * 8; tok0 = b * SEQ + r * GRIDW + c0; wlim = GRIDW; up_ok = r > 0; dn_ok = r < SEQ / GRIDW - 1; }
        else { const int b = seg >> 5; c0 = (seg & 31) * 8; tok0 = ML + b * CTXL + c0; wlim = CTXL; up_ok = false; dn_ok = false; }
        const int ch = cc * 256 + lane * 4;
        const float* wq = W9 + ch;
        f32x4 w[9];
#pragma unroll
        for (int k = 0; k < 9; ++k) w[k] = *(const f32x4*)(wq + (size_t)k * FFN);
        const f32x4 bias4 = *(const f32x4*)(Bc + ch);
        const bf16_t* ubase = UV + (size_t)tok0 * NUP + ch;
        u32x2 u[3][10];
#pragma unroll
        for (int dy = 0; dy < 3; ++dy) {
            const bool rok = dy == 1 ? true : (dy == 0 ? up_ok : dn_ok);
#pragma unroll
            for (int j = 0; j < 10; ++j) {
                const int col = c0 - 1 + j; const bool ok = rok && col >= 0 && col < wlim;
                const unsigned msk = (unsigned)-(int)ok;
                const long off = (long)(((dy - 1) * GRIDW + (j - 1)) & (int)msk) * NUP;
                const u32x2 t = *(const u32x2*)(ubase + off);
                u[dy][j] = (u32x2){t.x & msk, t.y & msk};
            }
        }
        u32x2 vv[8];
#pragma unroll
        for (int t = 0; t < 8; ++t) vv[t] = *(const u32x2*)(ubase + (size_t)t * NUP + FFN);
#pragma unroll
        for (int t = 0; t < 8; ++t) {
            f32x4 a = bias4;
#pragma unroll
            for (int dy = 0; dy < 3; ++dy)
#pragma unroll
                for (int dx = 0; dx < 3; ++dx) {
                    const u32x2 x = u[dy][t + dx]; const f32x4 ww = w[dy * 3 + dx];
                    a.x += ww.x * bflo(x.x); a.y += ww.y * bfhi(x.x); a.z += ww.z * bflo(x.y); a.w += ww.w * bfhi(x.y);
                }
            const f32x2 g0 = gelu_pk((f32x2){a.x, a.y}), g1 = gelu_pk((f32x2){a.z, a.w});
            u32x2 o; o.x = pk2(g0.x * bflo(vv[t].x), g0.y * bfhi(vv[t].x)); o.y = pk2(g1.x * bflo(vv[t].y), g1.y * bfhi(vv[t].y));
            bf16_t* vp = UV + (size_t)(tok0 + t) * NUP + FFN + ch;
            if (!dry) *(u32x2*)vp = o; else asm volatile("" :: "v"(o));
        }
    }
}

__device__ __forceinline__ void final_norm(const Frame& F) {
    const int gw = F.vcu * NWAVES + F.wave, NGW = F.G * NWAVES, lane = F.lane;
    const float* ssq = (const float*)(F.ws + WS_SSQ); const bf16_t* xr = (const bf16_t*)(F.ws + WS_XR);
    for (int row = gw; row < ML; row += NGW) {
        const float rs = EpiCommon::rstd_of(ssq, row);
        float* p = F.out + (size_t)row * D;
#pragma unroll
        for (int q = 0; q < 4; ++q) { const int c = 256 * q + 4 * lane; const u32x2 xw = *(const u32x2*)(xr + (size_t)row * D + c); const f32x2 h0 = unpkh2(xw.x), h1 = unpkh2(xw.y); const f32x4 v = {h0.x, h0.y, h1.x, h1.y}, w = *(const f32x4*)(F.a->in[22] + c); *(f32x4*)(p + c) = v * rs * w; }
    }
}

constexpr int N_PHASES = 25;
#ifdef VGPR_CAP
__attribute__((amdgpu_num_vgpr(VGPR_CAP)))
#endif
__global__ void __launch_bounds__(NTHR, 2) dit_fwd(Args args) {
    extern __shared__ __attribute__((aligned(16))) unsigned char lds[];
    Frame F;
    F.lds = (LAS unsigned char*)lds;
    const int wave0 = __builtin_amdgcn_readfirstlane((int)threadIdx.x >> 6);
    F.tid = threadIdx.x; F.lane = F.tid & 63; F.wave = wave0;
    F.G = gridDim.x; { const int bx = blockIdx.x; F.vcu = (F.G % 8 == 0) ? (bx % 8) * (F.G / 8) + bx / 8 : bx; }
    F.a = &args; F.out = args.out; F.ws = args.ws;
    volatile LAS unsigned* MISC = (volatile LAS unsigned*)(F.lds + LDSCTL_OFF);
    for (int u = F.tid; u < 64; u += NTHR) MISC[u] = 0u;
    __syncthreads();
    const int lo = args.ph_lo, hi = args.ph_hi;
    XcdBarrier bar; bar.bar = (unsigned*)(F.ws + WS_CTL) + CW_BAR; bar.x = 0; bar.st = nullptr;
    if (hi - lo > 1) bar = xcd_barrier_post((unsigned*)(F.ws + WS_CTL) + CW_BAR, MISC + 8, F.tid);
#ifndef ONLY_PHASE
#define ONLY_PHASE -1
#endif
#define PHON(k) (ONLY_PHASE < 0 || ONLY_PHASE == ((k) < 2 ? (k) : ((k) == 24 ? 24 : 2 + ((k) - 2) % 11)))
#define IN(k) (PHON(k) && lo <= (k) && (k) < hi)
#define PHB() do { int ln_ = (int)__builtin_amdgcn_mbcnt_hi(~0u, __builtin_amdgcn_mbcnt_lo(~0u, 0u)); asm volatile("" : "+v"(ln_)); F.lane = ln_; F.wave = wave0; F.tid = wave0 * 64 + ln_; } while (0)
#define REP(t) for (int rep_ = (args.probe_mask >> (t)) & 1; rep_ >= 0; --rep_)
#define DRY (rep_ > 0)
#define SEAM(k) do { if (IN(k) && IN((k) + 1)) { PHB(); xcd_barrier(bar, F.tid); if ((args.probe_mask >> 13) & 1) xcd_barrier(bar, F.tid); } } while (0)
    bf16_t* Wb = (bf16_t*)(F.ws + WS_W);
    bf16_t* XB = (bf16_t*)F.out; bf16_t* XR = (bf16_t*)(F.ws + WS_XR); bf16_t* QV = (bf16_t*)(F.ws + WS_QV);
    float* SSQ = (float*)(F.ws + WS_SSQ);
    const float* MODF = (const float*)(F.ws + WS_MOD);

#define CTX_SUBS(EPI, nN) do { for (int q_ = (int)blockIdx.x; q_ < 2 * (nN) * 8; q_ += F.G) { const int s_ = (q_ & 7) * (2 * (nN)) + (q_ >> 3); \
        const pg8::Unit uu_{ML / 256 + ((s_ >> 3) & 1), s_ >> 4, -1}; pg8::gemm_sub<EPI>(F.lds, F.tid, g, uu_, s_ & 7, E); } } while (0)
#define CTX_SUB_CUS (F.G > 64 ? 64 : 0)
    if (IN(0)) { PHB(); REP(0) { mod_gemv(F); } } SEAM(0);
    if (IN(1)) { PHB(); REP(1) { convert_weights(F, 0, CV_IN); xb_init(F); } } SEAM(1);
#pragma unroll 1
    for (int l = 0; l < DEPTH; ++l) {
        const int pb = 2 + 11 * l;
        const float* modl = MODF + (size_t)l * 3 * NMOD;
        const bool ctx_full = (l == 0);
        const int Mfull = ctx_full ? MT : ML;
        if (IN(pb + 0)) REP(2) { PHB();
            int cx = (int)blockIdx.x; asm volatile("" : "+s"(cx));
            pg8::Gemm g{XB, Wb + WO_IN / 2, MT, 4096, D, D}; pg8::StaticOrder S; S.init(ML, 4096, F.G, cx);
            EpiG1 E{SSQ, (const float*)(F.ws + WS_BIASIN) + (size_t)l * 3 * PIN, QV, (unsigned short*)(F.ws + WS_S2), (unsigned short*)(F.ws + WS_S3)};
            EpiCommon::rstd_prologue(SSQ, S, F.tid);
            pg8::gemm_phase<EpiG1>(F.lds, F.tid, g, S, E);
            for (int s = F.vcu; s < 2 * 16 * 8; s += F.G) {
                if (l + 1 == DEPTH && (s >> 4) < 4) continue;
                const pg8::Unit uu{ML / 256 + ((s >> 3) & 1), s >> 4, -1}; pg8::gemm_sub<EpiG1>(F.lds, F.tid, g, uu, s & 7, E); }
        } SEAM(pb + 0);
#pragma unroll 1
        for (int sub = 0; sub < 3; ++sub) {
            const int ph = pb + 1 + sub;
            if (IN(ph)) { PHB(); REP(3 + sub) {
                const bool ctx_here = ctx_full && F.G > 32;
                if (sub == 0) hgrn_phase_a(F, l, ctx_here ? F.G - 16 : F.G);
                if (sub == 1) { hgrn_scan(F, DRY);
                    if (rep_ == 0) convert_weights(F, l, l == 0 ? CV_IN2 : CV_DOWN, F.G > 128 ? 128 : 0); }
                const int first = sub == 0 ? 512 + (F.G - 1 - (int)blockIdx.x) : (int)blockIdx.x, last = sub == 0 ? (ctx_here ? 528 : 0) : (sub == 1 ? (ctx_full && !ctx_here ? 528 : 0) : 512);
                unsigned crf[8] = {}, crq[8] = {}, crv[8] = {}; bool cpre = false;
                for (int it = (sub == 1 ? 512 + (F.G - 1 - (int)blockIdx.x) : first); it < last; it += F.G) hgrn_c_item(F, l, it, it + F.G < last ? it + F.G : -1, DRY, crf, crq, crv, cpre);
            } }
            SEAM(ph);
        }
        if (IN(pb + 4)) REP(6) { PHB(); const bool dry = DRY;
            pg8::Gemm g{XB, Wb + WO_IN / 2 + (size_t)4096 * D, Mfull, 5120, D, D}; pg8::StaticOrder S; S.init(Mfull, 5120, F.G, (int)blockIdx.x);
            EpiG2 E{SSQ, (const float*)(F.ws + WS_BIASIN) + (size_t)l * 3 * PIN, QV, (bf16_t*)(F.ws + WS_S2), (bf16_t*)(F.ws + WS_S3), (bf16_t*)(F.ws + WS_ST), dry};
            EpiCommon::rstd_prologue(SSQ, S, F.tid);
            pg8::gemm_phase<EpiG2>(F.lds, F.tid, g, S, E);
            if (l == 0 && rep_ == 0) convert_weights(F, 0, CV_HG | CV_CV | CV_OUT | CV_DOWN | CV_UP, (MT / 256 * 20) % 256);
        } SEAM(pb + 4);
        unsigned* SPL = (unsigned*)(F.ws + WS_CTL) + CW_SPLIT + l * 2048;
        if (IN(pb + 5)) { PHB(); REP(7) conv1d_phase(F, l, Mfull); PHB(); split_arrive(bar, SPL, F.tid); }
        if (IN(pb + 6)) REP(8) { PHB();
            { pg8::Gemm g{QV, Wb + WO_HG / 2, Mfull, D, D, 2048}; pg8::StaticOrder S; S.init(ML, D, F.G, (int)blockIdx.x);
              EpiY<1> E{(const bf16_t*)(F.ws + WS_S3), XB, nullptr}; pg8::gemm_phase<EpiY<1>>(F.lds, F.tid, g, S, E);
              if (l == 0) CTX_SUBS(EpiY<1>, 4); }
            PHB(); split_wait(bar, SPL, F.tid);
            { pg8::Gemm g{QV + 1024, Wb + WO_CV / 2, Mfull, D, D, 2048}; pg8::StaticOrder S; S.init(ML, D, F.G, (int)blockIdx.x);
              EpiY<2> E{(const bf16_t*)(F.ws + WS_ST), (bf16_t*)(F.ws + WS_S2), XB}; pg8::gemm_phase<EpiY<2>>(F.lds, F.tid, g, S, E);
              if (l == 0) CTX_SUBS(EpiY<2>, 4); }
            if (l == 0 && rep_ == 0) convert_weights(F, 1, CV_IN | CV_IN2, CTX_SUB_CUS);
        } SEAM(pb + 6);
        if (IN(pb + 7)) REP(9) { PHB(); const bool dry = DRY;
            pg8::Gemm g{(const bf16_t*)(F.ws + WS_S2), Wb + WO_OUT / 2, Mfull, D, D, D}; pg8::StaticOrder S; S.init(ML, D, F.G, (int)blockIdx.x);
            EpiRes E{l == 0 ? F.a->in[0] : nullptr, l == 0 ? F.a->in[2] : nullptr, XR, modl + 2 * D, F.a->in[17] + (size_t)l * D, modl + 4 * D, XB, SSQ, dry};
            pg8::gemm_phase<EpiRes>(F.lds, F.tid, g, S, E);
            if (l == 0) CTX_SUBS(EpiRes, 4);
            if (l == 0 && rep_ == 0) convert_weights(F, 1, CV_HG | CV_CV, CTX_SUB_CUS);
        } SEAM(pb + 7);
        if (IN(pb + 8)) REP(10) { PHB();
            pg8::Gemm g{XB, Wb + WO_UP / 2, Mfull, NUP, D, D}; pg8::StaticOrder S; S.init(Mfull, NUP, F.G, (int)blockIdx.x);
            EpiUp E{SSQ, (const float*)(F.ws + WS_BIASUP) + (size_t)l * 3 * NUP, (bf16_t*)(F.ws + WS_UV)};
            EpiCommon::rstd_prologue(SSQ, S, F.tid);
            pg8::gemm_phase<EpiUp>(F.lds, F.tid, g, S, E);
            if (l == 0 && rep_ == 0) convert_weights(F, 1, CV_OUT, (MT / 256 * 22) % 256);
        } SEAM(pb + 8);
        if (IN(pb + 9)) { PHB(); REP(11) conv2d_phase(F, l, ctx_full, DRY); } SEAM(pb + 9);
        if (IN(pb + 10)) REP(12) { PHB(); const bool dry = DRY;
            pg8::Gemm g{(const bf16_t*)(F.ws + WS_UV) + FFN, Wb + WO_DOWN / 2, Mfull, D, FFN, NUP}; pg8::StaticOrder S; S.init(ML, D, F.G, (int)blockIdx.x);
            if (l + 1 < DEPTH) {
                EpiRes E{nullptr, nullptr, XR, modl + 5 * D, F.a->in[6] + (size_t)(l + 1) * D, MODF + (size_t)(l + 1) * 3 * NMOD + 1 * D, XB, SSQ, dry};
                pg8::gemm_phase<EpiRes>(F.lds, F.tid, g, S, E);
                if (l == 0) CTX_SUBS(EpiRes, 4);
                if (rep_ == 0) convert_weights(F, 1, CV_UP, CTX_SUB_CUS);
            } else if (F.G == 256) {
                EpiFinal E{XR, F.out, modl + 5 * D, F.a->in[22], SSQ, (unsigned*)(F.ws + WS_CTL) + CW_FIN};
                pg8::gemm_phase<EpiFinal>(F.lds, F.tid, g, S, E);
            } else {
                EpiRes E{nullptr, nullptr, XR, modl + 5 * D, nullptr, MODF + 1 * D, XB, SSQ, dry};
                pg8::gemm_phase<EpiRes>(F.lds, F.tid, g, S, E);
            }
        } if (l + 1 < DEPTH || F.G != 256) SEAM(pb + 10);
    }
    if (IN(24) && F.G != 256) { PHB(); final_norm(F); }
#undef IN
#undef SEAM
}

extern "C" void kernel_launch(void* const* d_in, const int* in_sizes, int n_in, void* d_out, int out_size, void* d_ws, size_t ws_size, hipStream_t stream) {
    static int grid = 0;
    if (grid == 0) {
        if (n_in != 23 || out_size != ML * D || ws_size < WS_END + 16 * 65536) { fprintf(stderr, "kernel_launch: unexpected shapes (n_in %d out %d ws %zu)\n", n_in, out_size, ws_size); grid = -1; return; }
        int dev = 0, cus = 0;
        if (hipGetDevice(&dev) != hipSuccess || hipDeviceGetAttribute(&cus, hipDeviceAttributeMultiprocessorCount, dev) != hipSuccess) { grid = -1; return; }
        if (hipFuncSetAttribute((const void*)dit_fwd, hipFuncAttributeMaxDynamicSharedMemorySize, LDS_BYTES) != hipSuccess) { fprintf(stderr, "kernel_launch: hipFuncSetAttribute failed\n"); grid = -1; return; }
        (void)hipGetLastError();
        grid = cus;
    }
    if (grid < 0) return;
    (void)hipMemsetAsync((char*)d_ws + WS_CTL, 0, CTL_ZERO_BYTES, stream);
    Args a{};
    for (int i = 0; i < 23; ++i) a.in[i] = (const float*)d_in[i];
    a.out = (float*)d_out; a.ws = (unsigned char*)d_ws;
#ifdef PROBE_MASK
    a.probe_mask = PROBE_MASK;
#endif
#if MK_N_LAUNCHES == 1
    a.ph_lo = 0; a.ph_hi = N_PHASES;
    hipLaunchKernelGGL(dit_fwd, dim3(grid), dim3(NTHR), LDS_BYTES, stream, a);
#else
    for (int p = 0; p < N_PHASES; ++p) { a.ph_lo = p; a.ph_hi = p + 1; hipLaunchKernelGGL(dit_fwd, dim3(grid), dim3(NTHR), LDS_BYTES, stream, a); }
#endif
}
```
